# Optimizing an MI355X kernel written in HIP

```python
import jax, jax.numpy as jnp
from jax import lax
import numpy as np

D_MODEL = 1024
BATCH = 8
SEQ = 2048
DEPTH = 1

HEAD_DIM = 64
HEADS_PER_GROUP = 8
ATTN_PATTERNS = ((128, 1), (512, 4), (2048, 16))
N_ATTN_GROUPS = len(ATTN_PATTERNS)
ATTN_WIDTH = N_ATTN_GROUPS * HEADS_PER_GROUP * HEAD_DIM
ATTN_OUT = HEADS_PER_GROUP * HEAD_DIM
ATTN_BLOCK = 128
ROPE_THETA = 10000.0
GMLP_CHUNK = 128
GMLP_GROUPS = 8
GMLP_WIDTH = D_MODEL
GMLP_GROUP_DIM = GMLP_WIDTH // GMLP_GROUPS
N_BRANCHES = 2
IN_WIDTH = 3 * ATTN_WIDTH + 2 * GMLP_WIDTH + N_BRANCHES * D_MODEL
D_FF = 2816
ALPHA = (2 * DEPTH) ** 0.25
BETA = (8 * DEPTH) ** -0.25
LN_EPS = 1e-5

kernel_name = 'hybrid_dilated_attn_gmlp_macaron_deepnorm'


def layer_norm(x, g, b):
    xf = x.astype(jnp.float32)
    mu = jnp.mean(xf, -1, keepdims=True)
    var = jnp.mean(jnp.square(xf - mu), -1, keepdims=True)
    y = (xf - mu) * lax.rsqrt(var + LN_EPS) * g.astype(jnp.float32) + b.astype(jnp.float32)
    return y.astype(x.dtype)


def swiglu_ffn(x, w_gate, w_up, w_down):
    return (jax.nn.silu(x @ w_gate) * (x @ w_up)) @ w_down


def rotary(t, cos, sin):
    tf = t.astype(jnp.float32)
    t1, t2 = jnp.split(tf, 2, axis=-1)
    c = cos[:, :, None, None, :]
    s = sin[:, :, None, None, :]
    return jnp.concatenate([t1 * c - t2 * s, t2 * c + t1 * s], axis=-1).astype(t.dtype)


def dilated_window_attention(q, k, v, window, dilation):
    b, s, h, dh = q.shape
    w = window // dilation
    sub_len = s // dilation
    n_blk = -(-sub_len // ATTN_BLOCK)
    pad = n_blk * ATTN_BLOCK - sub_len

    def to_blocks(t):
        t = t.reshape(b, sub_len, dilation, h, dh).transpose(0, 2, 1, 3, 4)
        t = jnp.pad(t, ((0, 0), (0, 0), (0, pad), (0, 0), (0, 0)))
        return t.reshape(b, dilation, n_blk, ATTN_BLOCK, h, dh)

    def with_prev(t):
        prev = jnp.pad(t, ((0, 0), (0, 0), (1, 0), (0, 0), (0, 0), (0, 0)))[:, :, :-1]
        return jnp.concatenate([prev, t], axis=3)

    qb = to_blocks(q)
    kc = with_prev(to_blocks(k))
    vc = with_prev(to_blocks(v))
    scores = jnp.einsum('brnqhd,brnkhd->brnhqk', qb, kc,
                        preferred_element_type=jnp.float32) * (dh ** -0.5)
    blk = np.arange(n_blk)[:, None, None]
    qi = np.arange(ATTN_BLOCK)[None, :, None]
    kj = np.arange(2 * ATTN_BLOCK)[None, None, :]
    dist = qi + ATTN_BLOCK - kj
    kpos = (blk - 1) * ATTN_BLOCK + kj
    mask = (dist >= 0) & (dist <= w) & (kpos >= 0)
    scores = jnp.where(jnp.asarray(mask)[None, None, :, None], scores, -jnp.inf)
    m = jnp.max(scores, axis=-1, keepdims=True)
    p = jnp.exp(scores - m)
    l = jnp.sum(p, axis=-1, keepdims=True)
    o = jnp.einsum('brnhqk,brnkhd->brnqhd', p / l, vc.astype(jnp.float32))
    lse = (m + jnp.log(l))[..., 0].transpose(0, 1, 2, 4, 3)

    def from_blocks(t):
        t = t.reshape((b, dilation, n_blk * ATTN_BLOCK) + t.shape[4:])[:, :, :sub_len]
        t = jnp.swapaxes(t, 1, 2)
        return t.reshape((b, s) + t.shape[3:])

    return from_blocks(o), from_blocks(lse)


def hybrid_mixer(h, cos, sin, w_in, b_gates, gmlp_ln_g, gmlp_ln_b, gmlp_w_s, gmlp_b_s,
                 w_attn_branch, w_gmlp_branch, w_out):
    b, s, _ = h.shape
    proj = h @ w_in
    qkv, z, g = jnp.split(proj, [3 * ATTN_WIDTH, 3 * ATTN_WIDTH + 2 * GMLP_WIDTH], axis=-1)

    qkv = qkv.reshape(b, s, 3, N_ATTN_GROUPS, HEADS_PER_GROUP, HEAD_DIM)
    q = rotary(qkv[:, :, 0], cos, sin)
    k = rotary(qkv[:, :, 1], cos, sin)
    v = qkv[:, :, 2]
    outs, lses = [], []
    for gi, (window, dilation) in enumerate(ATTN_PATTERNS):
        o, lse = dilated_window_attention(q[:, :, gi], k[:, :, gi], v[:, :, gi], window, dilation)
        outs.append(o)
        lses.append(lse)
    wts = jax.nn.softmax(jnp.stack(lses), axis=0)
    y_attn = jnp.sum(wts[..., None] * jnp.stack(outs), axis=0).reshape(b, s, ATTN_OUT).astype(h.dtype)

    u, vg = jnp.split(jax.nn.gelu(z, approximate=False), 2, axis=-1)
    vg = layer_norm(vg, gmlp_ln_g, gmlp_ln_b)
    n_chunk = s // GMLP_CHUNK
    vg = vg.reshape(b, n_chunk, GMLP_CHUNK, GMLP_GROUPS, GMLP_GROUP_DIM)
    w_s = gmlp_w_s * jnp.tril(jnp.ones((GMLP_CHUNK, GMLP_CHUNK), gmlp_w_s.dtype))
    mixed = jnp.einsum('gts,bnsgc->bntgc', w_s, vg) + gmlp_b_s.T[:, :, None]
    y_gmlp = u * mixed.reshape(b, s, GMLP_WIDTH)

    branches = jnp.stack([y_attn @ w_attn_branch, y_gmlp @ w_gmlp_branch], axis=2)
    gates = jax.nn.sigmoid(g.reshape(b, s, N_BRANCHES, D_MODEL) + b_gates.reshape(N_BRANCHES, D_MODEL))
    return jnp.sum(gates * branches, axis=2) @ w_out


def setup_inputs(seed: int = 0) -> dict:
    key = jax.random.key(seed)
    ks = jax.random.split(key, 32)

    def nrm(k, shape, scale):
        return jax.random.normal(k, shape, jnp.float32) * scale

    d_s = D_MODEL ** -0.5
    w_in = jnp.concatenate([
        nrm(ks[2], (DEPTH, D_MODEL, ATTN_WIDTH), d_s),
        nrm(ks[3], (DEPTH, D_MODEL, ATTN_WIDTH), d_s),
        nrm(ks[4], (DEPTH, D_MODEL, ATTN_WIDTH), BETA * d_s),
        nrm(ks[5], (DEPTH, D_MODEL, 2 * GMLP_WIDTH), d_s),
        nrm(ks[6], (DEPTH, D_MODEL, N_BRANCHES * D_MODEL), d_s),
    ], axis=-1)
    return {
        'x': jax.random.normal(ks[0], (BATCH, SEQ, D_MODEL), jnp.float32),
        'positions': jnp.broadcast_to(jnp.arange(SEQ, dtype=jnp.int32), (BATCH, SEQ)),
        'ffn1_w_gate': nrm(ks[7], (DEPTH, D_MODEL, D_FF), d_s),
        'ffn1_w_up': nrm(ks[8], (DEPTH, D_MODEL, D_FF), d_s),
        'ffn1_w_down': nrm(ks[9], (DEPTH, D_FF, D_MODEL), BETA * D_FF ** -0.5),
        'ln1_g': 1.0 + nrm(ks[10], (DEPTH, D_MODEL), 0.02),
        'ln1_b': nrm(ks[11], (DEPTH, D_MODEL), 0.02),
        'w_in': w_in,
        'b_gates': nrm(ks[12], (DEPTH, N_BRANCHES * D_MODEL), 0.02),
        'gmlp_ln_g': 1.0 + nrm(ks[13], (DEPTH, GMLP_WIDTH), 0.02),
        'gmlp_ln_b': nrm(ks[14], (DEPTH, GMLP_WIDTH), 0.02),
        'gmlp_w_s': nrm(ks[15], (DEPTH, GMLP_GROUPS, GMLP_CHUNK, GMLP_CHUNK), 0.5 * GMLP_CHUNK ** -0.5),
        'gmlp_b_s': 1.0 + nrm(ks[16], (DEPTH, GMLP_GROUPS, GMLP_CHUNK), 0.02),
        'w_attn_branch': nrm(ks[17], (DEPTH, ATTN_OUT, D_MODEL), BETA * ATTN_OUT ** -0.5),
        'w_gmlp_branch': nrm(ks[18], (DEPTH, GMLP_WIDTH, D_MODEL), BETA * GMLP_WIDTH ** -0.5),
        'w_out': nrm(ks[19], (DEPTH, D_MODEL, D_MODEL), BETA * d_s),
        'ln2_g': 1.0 + nrm(ks[20], (DEPTH, D_MODEL), 0.02),
        'ln2_b': nrm(ks[21], (DEPTH, D_MODEL), 0.02),
        'ffn2_w_gate': nrm(ks[22], (DEPTH, D_MODEL, D_FF), d_s),
        'ffn2_w_up': nrm(ks[23], (DEPTH, D_MODEL, D_FF), d_s),
        'ffn2_w_down': nrm(ks[24], (DEPTH, D_FF, D_MODEL), BETA * D_FF ** -0.5),
        'ln3_g': 1.0 + nrm(ks[25], (DEPTH, D_MODEL), 0.02),
        'ln3_b': nrm(ks[26], (DEPTH, D_MODEL), 0.02),
    }


def reference(x, positions, ffn1_w_gate, ffn1_w_up, ffn1_w_down, ln1_g, ln1_b, w_in, b_gates,
              gmlp_ln_g, gmlp_ln_b, gmlp_w_s, gmlp_b_s, w_attn_branch, w_gmlp_branch, w_out,
              ln2_g, ln2_b, ffn2_w_gate, ffn2_w_up, ffn2_w_down, ln3_g, ln3_b):
    inv_freq = ROPE_THETA ** (-jnp.arange(0, HEAD_DIM, 2, dtype=jnp.float32) / HEAD_DIM)
    ang = positions.astype(jnp.float32)[..., None] * inv_freq
    cos, sin = jnp.cos(ang), jnp.sin(ang)
    h = x
    for l in range(DEPTH):
        h = layer_norm(ALPHA * h + 0.5 * swiglu_ffn(h, ffn1_w_gate[l], ffn1_w_up[l], ffn1_w_down[l]),
                       ln1_g[l], ln1_b[l])
        mix = hybrid_mixer(h, cos, sin, w_in[l], b_gates[l], gmlp_ln_g[l], gmlp_ln_b[l], gmlp_w_s[l],
                           gmlp_b_s[l], w_attn_branch[l], w_gmlp_branch[l], w_out[l])
        h = layer_norm(ALPHA * h + mix, ln2_g[l], ln2_b[l])
        h = layer_norm(ALPHA * h + 0.5 * swiglu_ffn(h, ffn2_w_gate[l], ffn2_w_up[l], ffn2_w_down[l]),
                       ln3_g[l], ln3_b[l])
    return h
```

```cpp
#include <hip/hip_runtime.h>
#include <hip/hip_cooperative_groups.h>
#include <cstdio>
#include <cstdint>
#include <cmath>
namespace pg8 {
#define PG8_LAS __attribute__((address_space(3)))
typedef unsigned short bf16_t;
typedef short bf16x8 __attribute__((ext_vector_type(8)));
typedef float f32x4 __attribute__((ext_vector_type(4)));
typedef unsigned u32x4 __attribute__((ext_vector_type(4)));
constexpr int BM = 256, BK = 64, HALF = 128, HTB = HALF * BK * 2  , STAGE_BYTES = 8 * HTB, NXCD = 8, WGM = 8;

__host__ __device__ __forceinline__ int lds_byte(int r, int c) { const int st = (r >> 4) * 2 + (c >> 5), rr = r & 15, cc = c & 31, ob = rr * 64 + cc * 2; return st * 1024 + (ob ^ (((ob >> 9) & 1) << 5)); }
__host__ __device__ __forceinline__ void stage_rc(int b, int& R, int& C) { const int st = b / 1024, sb = b % 1024, swz = sb ^ (((sb >> 9) & 1) << 5); R = (st >> 1) * 16 + swz / 64; C = (st & 1) * 32 + (swz % 64) / 2; }
__host__ __device__ __forceinline__ int perm32(int rho) { const int n = rho >> 4, i = rho & 15; return 8 * (i >> 2) + 4 * n + (i & 3); }

struct Unit { int pm, pn; };
struct Gemm { const bf16_t* A; const bf16_t* Bt; int M, N, K; };

struct StaticOrder {
    int nM, nN, nwg, G, c;
    __host__ __device__ void init(int M, int N, int G_, int c_) { nM = M / BM; nN = N / BM; nwg = nM * nN; G = G_; c = c_; }
    __host__ __device__ bool next(int i, Unit& u) const {
        const long L = (long)i * G + c; if (L >= nwg) return false;
        int wgid = (int)L; { const int q = nwg / NXCD, r = nwg % NXCD, xcd = wgid % NXCD, off = wgid / NXCD; wgid = (xcd < r ? xcd * (q + 1) : r * (q + 1) + (xcd - r) * q) + off; }
        const int nig = WGM * nN, gid = wgid / nig, fm = gid * WGM, gsz = (nM - fm) < WGM ? (nM - fm) : WGM;
        u.pm = fm + ((wgid % nig) % gsz); u.pn = (wgid % nig) / gsz; return true;
    }
    __device__ __forceinline__ void a_ready(const Unit&) const {}
    __device__ __forceinline__ void done(const Unit&) const {}
};

__device__ __forceinline__ unsigned cvt_pk_bf16(float lo, float hi) { unsigned r; asm volatile("v_cvt_pk_bf16_f32 %0, %1, %2" : "=v"(r) : "v"(lo), "v"(hi)); return r; }
typedef float f32x2 __attribute__((ext_vector_type(2)));
__device__ __forceinline__ f32x2 gelu_pk(f32x2 v) {
    const f32x2 av = __builtin_elementwise_abs(v), d = av * 0.2316418882f + 1.0f;
    f32x2 t; t.x = __builtin_amdgcn_rcpf(d.x); t.y = __builtin_amdgcn_rcpf(d.y);
    f32x2 q = t * 0.5307027145f + (-0.7265760135f); q = q * t + 0.7107068705f; q = q * t + (-0.142248368f); q = q * t + 0.127414796f; q = q * t;
    const f32x2 s = (v * v) * (-0.72134752044f);
    f32x2 e; e.x = __builtin_amdgcn_exp2f(s.x); e.y = __builtin_amdgcn_exp2f(s.y);
    const f32x2 m = v * (q * e), r = v - m;
    f32x2 o; o.x = v.x < 0.f ? m.x : r.x; o.y = v.y < 0.f ? m.y : r.y; return o;
}
template <class Epi, class Sched, bool ALIGN_EPI = false, bool SP2 = false>
__device__ __forceinline__ void gemm_phase(PG8_LAS unsigned char* lds, const Gemm g, const Sched& S, const Epi& E) {
    const int tid = threadIdx.x, wid = __builtin_amdgcn_readfirstlane(tid >> 6), lane = tid & 63, wr = wid >> 2, wc = wid & 3, fr = lane & 15, fq = lane >> 4;
    const int K = g.K, nt = K / BK;
    unsigned voffA[2], voffB[2];
#pragma unroll
    for (int i = 0; i < 2; ++i) { int R, C; stage_rc(tid * 16 + i * 8192, R, C); const int Rb = Epi::PERM ? ((R & ~31) + perm32(R & 31)) : R;
        voffA[i] = (unsigned)(R * K + C) * 2u; voffB[i] = (unsigned)(Rb * K + C) * 2u; }
    const size_t kstep = (size_t)(BK * 2);
    const size_t hstep = (size_t)HALF * K * 2;
    const size_t tstep = 2 * hstep;
    const unsigned ldsw = (unsigned)wid * 1024u;
    const int aoff = lds_byte(wr * 64 + fr, fq * 8), boff = lds_byte(wc * 32 + fr, fq * 8);
#define PG8_SA(b, h) (((b) * 2 + (h)) * HTB)
#define PG8_SB(b, h) ((4 + (b) * 2 + (h)) * HTB)
#define PG8_STAGE(bufoff, gbase, voff) do { _Pragma("unroll") for (int _i = 0; _i < 2; ++_i) \
        __builtin_amdgcn_global_load_lds((const unsigned*)((const char*)(gbase) + (voff)[_i]), (PG8_LAS unsigned*)(lds + (bufoff) + ldsw + _i * 8192), 16, 0, 0); } while (0)
#define PG8_LDA(dst, b, h) do { _Pragma("unroll") for (int m = 0; m < 4; ++m) _Pragma("unroll") for (int k = 0; k < 2; ++k) dst[m][k] = *(const PG8_LAS bf16x8*)(lds + PG8_SA(b, h) + aoff + m * 2048 + k * 1024); } while (0)
#define PG8_LDB(dst, b, h) do { _Pragma("unroll") for (int n = 0; n < 2; ++n) _Pragma("unroll") for (int k = 0; k < 2; ++k) dst[n][k] = *(const PG8_LAS bf16x8*)(lds + PG8_SB(b, h) + boff + n * 2048 + k * 1024); } while (0)
#define PG8_MMA(ai, bj, At, Bt) do { __builtin_amdgcn_s_setprio(1); _Pragma("unroll") for (int m = 0; m < 4; ++m) _Pragma("unroll") for (int n = 0; n < 2; ++n) _Pragma("unroll") for (int k = 0; k < 2; ++k) \
        acc[ai][bj][m][n] = __builtin_amdgcn_mfma_f32_16x16x32_bf16(Bt[n][k], At[m][k], acc[ai][bj][m][n], 0, 0, 0); __builtin_amdgcn_s_setprio(0); } while (0)
#define PG8_WAIT_V(n) asm volatile("s_waitcnt vmcnt(" #n ")" ::: "memory")
#define PG8_WAIT_L(n) asm volatile("s_waitcnt lgkmcnt(" #n ")" ::: "memory")
#define PG8_BAR __builtin_amdgcn_s_barrier()
#define PG8_SCHED __builtin_amdgcn_sched_barrier(0)
    Unit cur, nxt; int ui = 0;
    if (!S.next(0, cur)) return;
    f32x4 acc[2][2][4][2];
#pragma unroll
    for (int a = 0; a < 2; ++a)
#pragma unroll
        for (int b = 0; b < 2; ++b)
#pragma unroll
            for (int m = 0; m < 4; ++m)
#pragma unroll
                for (int n = 0; n < 2; ++n) acc[a][b][m][n] = (f32x4){0.f, 0.f, 0.f, 0.f};
    bf16x8 At[4][2], B0[2][2], B1[2][2];
    const char* cA = (const char*)g.A + (size_t)cur.pm * tstep; const char* cB = (const char*)g.Bt + (size_t)cur.pn * tstep;
    S.a_ready(cur);
    if constexpr (SP2) {
        PG8_STAGE(PG8_SB(0, 0), cB, voffB); PG8_STAGE(PG8_SB(0, 1), cB + hstep, voffB); PG8_STAGE(PG8_SA(0, 0), cA, voffA); PG8_STAGE(PG8_SA(0, 1), cA + hstep, voffA);
        if (wr == 1) PG8_BAR;
        PG8_WAIT_V(2); PG8_BAR;
        PG8_STAGE(PG8_SB(1, 0), cB + kstep, voffB); PG8_STAGE(PG8_SA(1, 0), cA + kstep, voffA); PG8_STAGE(PG8_SB(1, 1), cB + hstep + kstep, voffB);
        PG8_WAIT_V(6); PG8_BAR;
    } else {
        PG8_STAGE(PG8_SB(0, 0), cB, voffB); PG8_STAGE(PG8_SA(0, 0), cA, voffA); PG8_STAGE(PG8_SB(0, 1), cB + hstep, voffB); PG8_STAGE(PG8_SA(0, 1), cA + hstep, voffA);
        if (wr == 1) PG8_BAR;
        PG8_WAIT_V(4); PG8_BAR;
        PG8_STAGE(PG8_SB(1, 0), cB + kstep, voffB); PG8_STAGE(PG8_SA(1, 0), cA + kstep, voffA); PG8_STAGE(PG8_SB(1, 1), cB + hstep + kstep, voffB);
        PG8_WAIT_V(6); PG8_BAR;
    }
    for (;;) {
        const bool has_next = S.next(ui + 1, nxt);
        const char* nA = has_next ? (const char*)g.A + (size_t)nxt.pm * tstep : cA; const char* nB = has_next ? (const char*)g.Bt + (size_t)nxt.pn * tstep : cB;
        for (int t = 0; t < nt; t += 2) {
            const bool last = (t == nt - 2);
            const char* a1 = cA + (size_t)(t + 1) * kstep;
            const char* a2 = last ? nA : cA + (size_t)(t + 2) * kstep; const char* b2 = last ? nB : cB + (size_t)(t + 2) * kstep;
            const char* a3 = a2 + kstep; const char* b3 = b2 + kstep;
            if (last && has_next) S.a_ready(nxt);
            if constexpr (SP2) {
            PG8_LDB(B0, 0, 0); PG8_LDB(B1, 0, 1); PG8_SCHED; PG8_LDA(At, 0, 0); PG8_STAGE(PG8_SA(1, 1), a1 + hstep, voffA);
            PG8_WAIT_V(8); PG8_WAIT_L(0); PG8_BAR; PG8_MMA(0, 0, At, B0); PG8_MMA(0, 1, At, B1); PG8_BAR; PG8_SCHED;
            PG8_LDA(At, 0, 1); PG8_STAGE(PG8_SB(0, 0), b2, voffB); PG8_STAGE(PG8_SB(0, 1), b2 + hstep, voffB); PG8_STAGE(PG8_SA(0, 0), a2, voffA);
            PG8_WAIT_V(8); PG8_WAIT_L(0); PG8_BAR; PG8_MMA(1, 0, At, B0); PG8_MMA(1, 1, At, B1); PG8_BAR; PG8_SCHED;
            PG8_LDB(B0, 1, 0); PG8_LDB(B1, 1, 1); PG8_SCHED; PG8_LDA(At, 1, 0); PG8_STAGE(PG8_SA(0, 1), a2 + hstep, voffA);
            PG8_WAIT_V(8); PG8_WAIT_L(0); PG8_BAR; PG8_MMA(0, 0, At, B0); PG8_MMA(0, 1, At, B1); PG8_BAR; PG8_SCHED;
            PG8_LDA(At, 1, 1); PG8_STAGE(PG8_SB(1, 0), b3, voffB); PG8_STAGE(PG8_SB(1, 1), b3 + hstep, voffB); PG8_STAGE(PG8_SA(1, 0), a3, voffA);
            PG8_WAIT_V(8); PG8_WAIT_L(0); PG8_BAR; PG8_MMA(1, 0, At, B0); PG8_MMA(1, 1, At, B1); PG8_BAR; PG8_SCHED;
            } else {
            PG8_LDB(B0, 0, 0); PG8_SCHED; PG8_LDA(At, 0, 0); PG8_STAGE(PG8_SA(1, 1), a1 + hstep, voffA);
            PG8_WAIT_L(8); PG8_BAR; PG8_WAIT_L(0); PG8_MMA(0, 0, At, B0); PG8_BAR; PG8_SCHED;
            PG8_LDB(B1, 0, 1); PG8_STAGE(PG8_SB(0, 0), b2, voffB);
            PG8_BAR; PG8_WAIT_L(0); PG8_MMA(0, 1, At, B1); PG8_BAR;
            PG8_LDA(At, 0, 1); PG8_STAGE(PG8_SA(0, 0), a2, voffA);
            PG8_BAR; PG8_WAIT_L(0); PG8_MMA(1, 0, At, B0); PG8_BAR; PG8_SCHED;
            PG8_STAGE(PG8_SB(0, 1), b2 + hstep, voffB);
            PG8_WAIT_V(6); PG8_BAR; PG8_MMA(1, 1, At, B1); PG8_BAR;
            PG8_LDB(B0, 1, 0); PG8_SCHED; PG8_LDA(At, 1, 0); PG8_STAGE(PG8_SA(0, 1), a2 + hstep, voffA);
            PG8_WAIT_L(8); PG8_BAR; PG8_WAIT_L(0); PG8_MMA(0, 0, At, B0); PG8_BAR; PG8_SCHED;
            PG8_LDB(B1, 1, 1); PG8_STAGE(PG8_SB(1, 0), b3, voffB);
            PG8_BAR; PG8_WAIT_L(0); PG8_MMA(0, 1, At, B1); PG8_BAR;
            PG8_LDA(At, 1, 1); PG8_STAGE(PG8_SA(1, 0), a3, voffA);
            PG8_BAR; PG8_WAIT_L(0); PG8_MMA(1, 0, At, B0); PG8_BAR; PG8_SCHED;
            PG8_STAGE(PG8_SB(1, 1), b3 + hstep, voffB);
            PG8_WAIT_V(6); PG8_BAR; PG8_MMA(1, 1, At, B1); PG8_BAR;
            }
        }
        if constexpr (ALIGN_EPI) { if (wr == 0) PG8_BAR; }
        if constexpr (!Epi::AFTER_DRAIN) { E(acc, cur, wr, wc, fr, fq); S.done(cur); }
        if (!has_next) break;
#pragma unroll
        for (int a = 0; a < 2; ++a)
#pragma unroll
            for (int b = 0; b < 2; ++b)
#pragma unroll
                for (int m = 0; m < 4; ++m)
#pragma unroll
                    for (int n = 0; n < 2; ++n) acc[a][b][m][n] = (f32x4){0.f, 0.f, 0.f, 0.f};
        cur = nxt; cA = nA; cB = nB; ++ui;
        if constexpr (ALIGN_EPI) { if (wr == 1) PG8_BAR; }
    }
    PG8_WAIT_V(0);
    if constexpr (!ALIGN_EPI) { if (wr == 0) PG8_BAR; }
    PG8_BAR;
    if constexpr (Epi::AFTER_DRAIN) { E.fused(acc, cur, wr, wc, fr, fq, lds, wid, lane); S.done(cur); }
#undef PG8_SA
#undef PG8_SB
#undef PG8_STAGE
#undef PG8_LDA
#undef PG8_LDB
#undef PG8_MMA
#undef PG8_WAIT_V
#undef PG8_WAIT_L
#undef PG8_BAR
#undef PG8_SCHED
}
}

namespace cg = cooperative_groups;
#define LAS __attribute__((address_space(3)))
using pg8::bf16_t; using pg8::bf16x8; using pg8::f32x4; using pg8::u32x4; using pg8::Unit;
typedef float f32x2_t __attribute__((ext_vector_type(2))); typedef __bf16 bf16x2_t __attribute__((ext_vector_type(2)));
__device__ __forceinline__ unsigned cvt_pk_bf16(float lo, float hi) { f32x2_t v = {lo, hi}; bf16x2_t b = __builtin_convertvector(v, bf16x2_t); return __builtin_bit_cast(unsigned, b); }
typedef unsigned u32x2 __attribute__((ext_vector_type(2)));
typedef short s16x4 __attribute__((ext_vector_type(4)));

constexpr int M = 16384, D = 1024, SEQ = 2048, DFF = 2816, AW = 1536, NWAVES = 8, NIN = 8704;
constexpr float ALPHA = 1.189207115002721f;
constexpr float LN_EPS = 1e-5f;
constexpr float QSCALE = 0.125f * 1.4426950408889634f;

constexpr size_t MiB = 1u << 20;
constexpr size_t WS_STATS = 0;
constexpr size_t WS_WIN = 1 * MiB, WS_WA = 18 * MiB, WS_WG = 19 * MiB, WS_WO = 21 * MiB, WS_W2GU = 23 * MiB, WS_W2D = 34 * MiB;
constexpr size_t WS_COS = 40 * MiB, WS_SIN = 42 * MiB, WS_LSE = 44 * MiB, WS_WSB = 45 * MiB + 512 * 1024;
constexpr size_t WS_W1GU = 46 * MiB, WS_W1D = 57 * MiB;
constexpr size_t WS_XB = 64 * MiB, WS_ACT1 = 96 * MiB, WS_PRE1 = 184 * MiB;
constexpr size_t WS_Q = 46 * MiB, WS_K = 94 * MiB, WS_V = 142 * MiB, WS_U = 190 * MiB, WS_VG = 222 * MiB;
constexpr size_t WS_GATES = 94 * MiB, WS_YATT = 158 * MiB, WS_MRG = 222 * MiB;
constexpr size_t WS_PRE2 = 94 * MiB, WS_H2B = 46 * MiB, WS_ACT2 = 160 * MiB;
constexpr size_t WS_END = 256 * MiB;
constexpr int LDS_BYTES = 135168;

__device__ __forceinline__ float bf_lo(unsigned w) { return __uint_as_float(w << 16); }
__device__ __forceinline__ float bf_hi(unsigned w) { return __uint_as_float(w & 0xffff0000u); }
__device__ __forceinline__ float fast_rcp(float x) { return __builtin_amdgcn_rcpf(x); }
__device__ __forceinline__ float sigmoidf_(float x) { return fast_rcp(1.f + __builtin_amdgcn_exp2f(-1.4426950408889634f * x)); }
__device__ __forceinline__ float wave_sum(float v) {
#pragma unroll
    for (int o = 1; o < 64; o <<= 1) v += __shfl_xor(v, o);
    return v;
}
__device__ __forceinline__ u32x4 pack8(const f32x4 a, const f32x4 b) {
    u32x4 w; w.x = cvt_pk_bf16(a[0], a[1]); w.y = cvt_pk_bf16(a[2], a[3]); w.z = cvt_pk_bf16(b[0], b[1]); w.w = cvt_pk_bf16(b[2], b[3]); return w;
}
__device__ __forceinline__ void unpack8(const u32x4 w, f32x4& a, f32x4& b) {
    a = (f32x4){bf_lo(w.x), bf_hi(w.x), bf_lo(w.y), bf_hi(w.y)}; b = (f32x4){bf_lo(w.z), bf_hi(w.z), bf_lo(w.w), bf_hi(w.w)};
}


struct EpiSwiGLU {
    static constexpr bool PERM = true, AFTER_DRAIN = false;
    bf16_t* O;
    __device__ __forceinline__ void operator()(const f32x4 (&acc)[2][2][4][2], const Unit& u, int wr, int wc, int fr, int fq) const {
        const int row0 = u.pm * 256 + wr * 64 + fr, col0 = u.pn * 128 + wc * 32 + 8 * fq;
#pragma unroll
        for (int ai = 0; ai < 2; ++ai)
#pragma unroll
            for (int m = 0; m < 4; ++m) {
                f32x4 o[2];
#pragma unroll
                for (int n = 0; n < 2; ++n) {
                    const f32x4 g = acc[ai][0][m][n], up = acc[ai][1][m][n];
#pragma unroll
                    for (int j = 0; j < 4; ++j) o[n][j] = g[j] * sigmoidf_(g[j]) * up[j];
                }
                *(u32x4*)(O + (size_t)(row0 + ai * 128 + m * 16) * DFF + col0) = pack8(o[0], o[1]);
            }
    }
};
struct EpiResid {
    static constexpr bool PERM = true, AFTER_DRAIN = false;
    const float* R; float* O; float alpha, scale;
    __device__ __forceinline__ void operator()(const f32x4 (&acc)[2][2][4][2], const Unit& u, int wr, int wc, int fr, int fq) const {
        const int row0 = u.pm * 256 + wr * 64 + fr, col0 = u.pn * 256 + wc * 32 + 8 * fq;
#pragma unroll
        for (int ai = 0; ai < 2; ++ai)
#pragma unroll
            for (int m = 0; m < 4; ++m)
#pragma unroll
                for (int bj = 0; bj < 2; ++bj) {
                    const size_t off = (size_t)(row0 + ai * 128 + m * 16) * D + col0 + bj * 128;
                    const f32x4 r0 = *(const f32x4*)(R + off), r1 = *(const f32x4*)(R + off + 4);
                    *(f32x4*)(O + off) = r0 * alpha + acc[ai][bj][m][0] * scale;
                    *(f32x4*)(O + off + 4) = r1 * alpha + acc[ai][bj][m][1] * scale;
                }
    }
};
struct EpiResidHL {
    static constexpr bool PERM = true, AFTER_DRAIN = false;
    const bf16_t* Rhi; const bf16_t* Rlo; float* O; float alpha;
    __device__ __forceinline__ void operator()(const f32x4 (&acc)[2][2][4][2], const Unit& u, int wr, int wc, int fr, int fq) const {
        const int row0 = u.pm * 256 + wr * 64 + fr, col0 = u.pn * 256 + wc * 32 + 8 * fq;
#pragma unroll
        for (int ai = 0; ai < 2; ++ai)
#pragma unroll
            for (int m = 0; m < 4; ++m)
#pragma unroll
                for (int bj = 0; bj < 2; ++bj) {
                    const size_t off = (size_t)(row0 + ai * 128 + m * 16) * D + col0 + bj * 128;
                    f32x4 h0, h1, l0, l1; unpack8(*(const u32x4*)(Rhi + off), h0, h1); unpack8(*(const u32x4*)(Rlo + off), l0, l1);
                    *(f32x4*)(O + off) = (h0 + l0) * alpha + acc[ai][bj][m][0];
                    *(f32x4*)(O + off + 4) = (h1 + l1) * alpha + acc[ai][bj][m][1];
                }
    }
};
struct EpiGate {
    static constexpr bool PERM = true, AFTER_DRAIN = false;
    bf16_t* O; const float* bias;
    __device__ __forceinline__ void operator()(const f32x4 (&acc)[2][2][4][2], const Unit& u, int wr, int wc, int fr, int fq) const {
        const int row0 = u.pm * 256 + wr * 64 + fr, col0 = u.pn * 256 + wc * 32 + 8 * fq;
#pragma unroll
        for (int bj = 0; bj < 2; ++bj) {
            const f32x4 b0 = *(const f32x4*)(bias + col0 + bj * 128), b1 = *(const f32x4*)(bias + col0 + bj * 128 + 4);
#pragma unroll
            for (int ai = 0; ai < 2; ++ai)
#pragma unroll
                for (int m = 0; m < 4; ++m) {
                    f32x4 o0 = acc[ai][bj][m][0] + b0, o1 = acc[ai][bj][m][1] + b1;
#pragma unroll
                    for (int j = 0; j < 4; ++j) { o0[j] = sigmoidf_(o0[j]); o1[j] = sigmoidf_(o1[j]); }
                    *(u32x4*)(O + (size_t)(row0 + ai * 128 + m * 16) * 2048 + col0 + bj * 128) = pack8(o0, o1);
                }
        }
    }
};
template <int MODE> struct EpiBranch {
    static constexpr bool PERM = true, AFTER_DRAIN = false;
    bf16_t* T; const bf16_t* G; int goff;
    __device__ __forceinline__ void operator()(const f32x4 (&acc)[2][2][4][2], const Unit& u, int wr, int wc, int fr, int fq) const {
        const int row0 = u.pm * 256 + wr * 64 + fr, col0 = u.pn * 256 + wc * 32 + 8 * fq;
#pragma unroll
        for (int ai = 0; ai < 2; ++ai)
#pragma unroll
            for (int m = 0; m < 4; ++m)
#pragma unroll
                for (int bj = 0; bj < 2; ++bj) {
                    const size_t row = (size_t)(row0 + ai * 128 + m * 16);
                    f32x4 g0, g1; unpack8(*(const u32x4*)(G + row * 2048 + goff + col0 + bj * 128), g0, g1);
                    f32x4 o0 = g0 * acc[ai][bj][m][0], o1 = g1 * acc[ai][bj][m][1];
                    bf16_t* tp = T + row * D + col0 + bj * 128;
                    if (MODE == 1) { f32x4 t0, t1; unpack8(*(const u32x4*)tp, t0, t1); o0 += t0; o1 += t1; }
                    *(u32x4*)tp = pack8(o0, o1);
                }
    }
};
struct EpiIn {
    static constexpr bool PERM = true, AFTER_DRAIN = false;
    bf16_t *Q, *K, *V, *U, *VG; const float* cosT; const float* sinT; float* stats;
    __device__ __forceinline__ void operator()(const f32x4 (&acc)[2][2][4][2], const Unit& u, int wr, int wc, int fr, int fq) const {
        const int row0 = u.pm * 256 + wr * 64 + fr, pn = u.pn;
        if (pn < 12) {
            bf16_t* dst = pn < 6 ? Q : K; const float sc = pn < 6 ? QSCALE : 1.f; const int cb = 256 * (pn < 6 ? pn : pn - 6) + 64 * wc + 8 * fq;
#pragma unroll
            for (int ai = 0; ai < 2; ++ai)
#pragma unroll
                for (int m = 0; m < 4; ++m) {
                    const size_t row = (size_t)(row0 + ai * 128 + m * 16);
                    f32x4 o1[2], o2[2];
#pragma unroll
                    for (int n = 0; n < 2; ++n) {
                        const f32x4 c = *(const f32x4*)(cosT + row * 32 + 8 * fq + 4 * n) * sc, s = *(const f32x4*)(sinT + row * 32 + 8 * fq + 4 * n) * sc;
                        const f32x4 t1 = acc[ai][0][m][n], t2 = acc[ai][1][m][n];
                        o1[n] = t1 * c - t2 * s; o2[n] = t2 * c + t1 * s;
                    }
                    *(u32x4*)(dst + row * AW + cb) = pack8(o1[0], o1[1]);
                    *(u32x4*)(dst + row * AW + cb + 32) = pack8(o2[0], o2[1]);
                }
        } else if (pn < 18) {
            const int cb = 256 * (pn - 12) + 32 * wc + 8 * fq;
#pragma unroll
            for (int ai = 0; ai < 2; ++ai)
#pragma unroll
                for (int m = 0; m < 4; ++m)
#pragma unroll
                    for (int bj = 0; bj < 2; ++bj)
                        *(u32x4*)(V + (size_t)(row0 + ai * 128 + m * 16) * AW + cb + bj * 128) = pack8(acc[ai][bj][m][0], acc[ai][bj][m][1]);
        } else {
            const bool isvg = pn >= 22; bf16_t* dst = isvg ? VG : U; const int cb = 256 * ((pn - 18) & 3) + 32 * wc + 8 * fq;
#pragma unroll
            for (int ai = 0; ai < 2; ++ai)
#pragma unroll
                for (int m = 0; m < 4; ++m) {
                    const size_t row = (size_t)(row0 + ai * 128 + m * 16);
                    float s1 = 0.f, s2 = 0.f;
#pragma unroll
                    for (int bj = 0; bj < 2; ++bj) {
                        const f32x4 a = acc[ai][bj][m][0], b = acc[ai][bj][m][1];
                        const pg8::f32x2 g0 = pg8::gelu_pk((pg8::f32x2){a[0], a[1]}), g1 = pg8::gelu_pk((pg8::f32x2){a[2], a[3]}), g2 = pg8::gelu_pk((pg8::f32x2){b[0], b[1]}), g3 = pg8::gelu_pk((pg8::f32x2){b[2], b[3]});
                        u32x4 w; w.x = cvt_pk_bf16(g0.x, g0.y); w.y = cvt_pk_bf16(g1.x, g1.y); w.z = cvt_pk_bf16(g2.x, g2.y); w.w = cvt_pk_bf16(g3.x, g3.y);
                        *(u32x4*)(dst + row * D + cb + bj * 128) = w;
                        s1 += (g0.x + g0.y) + (g1.x + g1.y) + (g2.x + g2.y) + (g3.x + g3.y);
                        s2 += (g0.x * g0.x + g0.y * g0.y) + (g1.x * g1.x + g1.y * g1.y) + (g2.x * g2.x + g2.y * g2.y) + (g3.x * g3.x + g3.y * g3.y);
                    }
                    if (isvg) {
                        s1 += __shfl_xor(s1, 16); s1 += __shfl_xor(s1, 32); s2 += __shfl_xor(s2, 16); s2 += __shfl_xor(s2, 32);
                        if (fq == 0) { atomicAdd(stats + row * 2, s1); atomicAdd(stats + row * 2 + 1, s2); }
                    }
                }
        }
    }
};

__device__ __forceinline__ unsigned f2bf(float f) { unsigned u = __builtin_bit_cast(unsigned, f); return (u + 0x7fffu + ((u >> 16) & 1u)) >> 16; }
__device__ __forceinline__ unsigned pk2(float lo, float hi) { return f2bf(lo) | (f2bf(hi) << 16); }

__device__ __forceinline__ void tr_item(const float* W, int ldN, int ncol0, int k0, bf16_t* WT, int K, int prow0, LAS float* scr, int lane) {
#pragma unroll 8
    for (int i = 0; i < 32; ++i) { const int kk = 2 * i + (lane >> 5); scr[kk * 33 + (lane & 31)] = W[(size_t)(k0 + kk) * ldN + ncol0 + (lane & 31)]; }
    asm volatile("s_waitcnt lgkmcnt(0)" ::: "memory");
    const int c = lane & 7;
#pragma unroll
    for (int j = 0; j < 4; ++j) { const int n = (lane >> 3) + 8 * j; const LAS float* s = scr + (8 * c) * 33 + n;
        u32x4 o; o.x = pk2(s[0 * 33], s[1 * 33]); o.y = pk2(s[2 * 33], s[3 * 33]); o.z = pk2(s[4 * 33], s[5 * 33]); o.w = pk2(s[6 * 33], s[7 * 33]);
        *(u32x4*)(WT + (size_t)(prow0 + n) * K + k0 + 8 * c) = o; }
    asm volatile("s_waitcnt lgkmcnt(0)" ::: "memory");
}
__device__ __forceinline__ void tr_plain(const float* W, int K, int N, bf16_t* WT, int item, LAS float* scr, int lane) {
    const int nblk = N / 32, kb = item / nblk, nb = item % nblk; tr_item(W, N, 32 * nb, 64 * kb, WT, K, 32 * nb, scr, lane);
}
__device__ __forceinline__ void tr_gu(const float* Wg, const float* Wu, bf16_t* WT, int item, LAS float* scr, int lane) {
    const int nblk = (2 * DFF) / 32, kb = item / nblk, nb = item % nblk, p0 = 32 * nb, tile = p0 >> 8, bj = (p0 >> 7) & 1, x = p0 & 127;
    tr_item(bj ? Wu : Wg, DFF, 128 * tile + x, 64 * kb, WT, D, p0, scr, lane);
}
__device__ __forceinline__ void tr_win(const float* W, bf16_t* WT, int item, LAS float* scr, int lane) {
    const int nblk = NIN / 32, kb = item / nblk, nb = item % nblk, p0 = 32 * nb;
    int nc = p0; if (p0 < 3072) { const int tile = p0 >> 8, bj = (p0 >> 7) & 1, wc = (p0 >> 5) & 3; nc = 256 * tile + 64 * wc + 32 * bj; }
    tr_item(W, NIN, nc, 64 * kb, WT, D, p0, scr, lane);
}

template <int MODE> __device__ __forceinline__ void ln_row(const float* xrow, const float* gam, const float* bet, float* of32, bf16_t* ob0, bf16_t* ob1, int lane) {
    const f32x4* xr = (const f32x4*)xrow + lane;
    f32x4 v[4]; float s = 0.f;
#pragma unroll
    for (int j = 0; j < 4; ++j) { v[j] = xr[64 * j]; s += (v[j][0] + v[j][1]) + (v[j][2] + v[j][3]); }
    const float mean = wave_sum(s) * (1.f / D); float s2 = 0.f;
#pragma unroll
    for (int j = 0; j < 4; ++j) { v[j] = v[j] - mean; s2 += (v[j][0] * v[j][0] + v[j][1] * v[j][1]) + (v[j][2] * v[j][2] + v[j][3] * v[j][3]); }
    const float rstd = 1.f / sqrtf(wave_sum(s2) * (1.f / D) + LN_EPS);
#pragma unroll
    for (int j = 0; j < 4; ++j) {
        const f32x4 g = ((const f32x4*)gam)[lane + 64 * j], b = ((const f32x4*)bet)[lane + 64 * j];
        const f32x4 y = v[j] * rstd * g + b;
        if (MODE >= 1) ((f32x4*)of32)[lane + 64 * j] = y;
        if (MODE <= 1) {
            u32x2 w; w.x = pk2(y[0], y[1]); w.y = pk2(y[2], y[3]);
            ((u32x2*)ob0)[lane + 64 * j] = w;
            if (MODE == 0) { u32x2 l; l.x = pk2(y[0] - bf_lo(w.x), y[1] - bf_hi(w.x)); l.y = pk2(y[2] - bf_lo(w.y), y[3] - bf_hi(w.y)); ((u32x2*)ob1)[lane + 64 * j] = l; }
        }
    }
}

__device__ __forceinline__ void sincos_d(float a, float& so, float& co) {
    const double x = (double)a, kq = __builtin_rint(x * 0.63661977236758134308), r = __builtin_fma(-kq, 1.57079632679489661923, x) - kq * 6.123233995736766e-17, r2 = r * r;
    double sp = -2.5052108385441720e-08; sp = sp * r2 + 2.7557319223985893e-06; sp = sp * r2 - 1.9841269841269841e-04; sp = sp * r2 + 8.3333333333333332e-03; sp = sp * r2 - 1.6666666666666666e-01; sp = sp * r2 * r + r;
    double cp = 2.0876756987868099e-09; cp = cp * r2 - 2.7557319223985888e-07; cp = cp * r2 + 2.4801587301587302e-05; cp = cp * r2 - 1.3888888888888889e-03; cp = cp * r2 + 4.1666666666666664e-02; cp = cp * r2 - 0.5; cp = cp * r2 + 1.0;
    const int q = ((int)kq) & 3;
    const double sv = (q == 0) ? sp : (q == 1) ? cp : (q == 2) ? -sp : -cp, cv = (q == 0) ? cp : (q == 1) ? -sp : (q == 2) ? -cp : sp;
    so = (float)sv; co = (float)cv;
}

constexpr int KROW = 144, ATT_KOFF = 0, ATT_VOFF = 256 * KROW;
__device__ __forceinline__ s16x4 tr_read(LAS unsigned char* p) { return __builtin_amdgcn_ds_read_tr16_b64_v4i16((LAS s16x4*)p); }
__device__ __forceinline__ void attn_unit(LAS unsigned char* lds, bf16_t* QO, const bf16_t* Kb, const bf16_t* Vb, float* lse, int unit, int tid, int wid, int lane) {
    const int rb = unit & 15, h = (unit >> 4) & 7, gb = unit >> 7, g = gb % 3, b = gb / 3;
    const int sh = 2 * g, dil = 1 << sh, lgn = 4 - sh, r = rb >> lgn, n = rb & ((1 << lgn) - 1);
    const int col0 = g * 512 + h * 64;
    const size_t rowb = (size_t)b * SEQ;
#pragma unroll
    for (int i = 0; i < 4; ++i) {
        const int idx = tid + i * 512, j = idx >> 3, ch = idx & 7, L = (n - 1) * 128 + j;
        u32x4 kv = {0u, 0u, 0u, 0u}, vv = {0u, 0u, 0u, 0u};
        if (L >= 0) { const size_t off = (rowb + (size_t)(L * dil + r)) * AW + col0 + ch * 8; kv = *(const u32x4*)(Kb + off); vv = *(const u32x4*)(Vb + off); }
        *(LAS u32x4*)(lds + ATT_KOFF + j * KROW + ch * 16) = kv; *(LAS u32x4*)(lds + ATT_VOFF + j * KROW + ch * 16) = vv;
    }
    const int l15 = lane & 15, fq = lane >> 4, qi = wid * 16 + l15;
    const size_t qrow = rowb + (size_t)((n * 128 + qi) * dil + r);
    const bf16x8 q0 = *(const bf16x8*)(QO + qrow * AW + col0 + fq * 8), q1 = *(const bf16x8*)(QO + qrow * AW + col0 + 32 + fq * 8);
    __syncthreads();
    f32x4 s[9];
#pragma unroll
    for (int jb = 0; jb < 9; ++jb) {
        LAS unsigned char* kp = lds + ATT_KOFF + ((wid + jb) * 16 + l15) * KROW + fq * 16;
        const bf16x8 k0 = *(LAS bf16x8*)kp, k1 = *(LAS bf16x8*)(kp + 64);
        f32x4 z = {0.f, 0.f, 0.f, 0.f};
        z = __builtin_amdgcn_mfma_f32_16x16x32_bf16(k0, q0, z, 0, 0, 0);
        s[jb] = __builtin_amdgcn_mfma_f32_16x16x32_bf16(k1, q1, z, 0, 0, 0);
    }
    float mx = -INFINITY;
#pragma unroll
    for (int jb = 0; jb < 9; ++jb)
#pragma unroll
        for (int i = 0; i < 4; ++i) {
            const int dlt = 16 * jb + 4 * fq + i - l15, kj = (wid + jb) * 16 + 4 * fq + i;
            const bool ok = dlt >= 0 && dlt <= 128 && (n > 0 || kj >= 128);
            s[jb][i] = ok ? s[jb][i] : -INFINITY; mx = fmaxf(mx, s[jb][i]);
        }
    mx = fmaxf(mx, __shfl_xor(mx, 16)); mx = fmaxf(mx, __shfl_xor(mx, 32));
    float sum = 0.f;
#pragma unroll
    for (int jb = 0; jb < 9; ++jb)
#pragma unroll
        for (int i = 0; i < 4; ++i) { const float p = __builtin_amdgcn_exp2f(s[jb][i] - mx); s[jb][i] = p; sum += p; }
    sum += __shfl_xor(sum, 16); sum += __shfl_xor(sum, 32);
    const float inv = 1.f / sum;
    bf16x8 pf[5];
    { const f32x4 z = {0.f, 0.f, 0.f, 0.f};
      pf[0] = __builtin_bit_cast(bf16x8, pack8(s[0], s[1])); pf[1] = __builtin_bit_cast(bf16x8, pack8(s[2], s[3])); pf[2] = __builtin_bit_cast(bf16x8, pack8(s[4], s[5]));
      pf[3] = __builtin_bit_cast(bf16x8, pack8(s[6], s[7])); pf[4] = __builtin_bit_cast(bf16x8, pack8(s[8], z)); }
    f32x4 o[4];
#pragma unroll
    for (int db = 0; db < 4; ++db) o[db] = (f32x4){0.f, 0.f, 0.f, 0.f};
    const int qq = l15 >> 2, pp = l15 & 3;
#pragma unroll
    for (int ks = 0; ks < 5; ++ks) {
        const int kb0 = wid + 2 * ks, kb1 = (wid + 2 * ks + 1) > 15 ? 15 : (wid + 2 * ks + 1);
        LAS unsigned char* a0 = lds + ATT_VOFF + (kb0 * 16 + 4 * fq + qq) * KROW + pp * 8;
        LAS unsigned char* a1 = lds + ATT_VOFF + (kb1 * 16 + 4 * fq + qq) * KROW + pp * 8;
#pragma unroll
        for (int db = 0; db < 4; ++db) {
            const s16x4 lo = tr_read(a0 + db * 32), hi = tr_read(a1 + db * 32);
            const bf16x8 vf = {lo[0], lo[1], lo[2], lo[3], hi[0], hi[1], hi[2], hi[3]};
            o[db] = __builtin_amdgcn_mfma_f32_16x16x32_bf16(vf, pf[ks], o[db], 0, 0, 0);
        }
    }
#pragma unroll
    for (int db = 0; db < 4; ++db) {
        u32x2 w; w.x = cvt_pk_bf16(o[db][0] * inv, o[db][1] * inv); w.y = cvt_pk_bf16(o[db][2] * inv, o[db][3] * inv);
        *(u32x2*)(QO + qrow * AW + col0 + db * 16 + 4 * fq) = w;
    }
    if (fq == 0) lse[((size_t)g * M + qrow) * 8 + h] = mx + __builtin_amdgcn_logf(sum);
    __syncthreads();
}

constexpr int GROW = 272;
__device__ __forceinline__ void gmlp_unit(LAS unsigned char* lds, bf16_t* UY, const bf16_t* VG, const float* stats, const float* lng, const float* lnb, const bf16_t* WsB, const float* bs,
                                          int unit, int tid, int wid, int lane) {
    const int g = unit & 7, n = (unit >> 3) & 15, b = unit >> 7;
    const size_t row0 = (size_t)b * SEQ + n * 128;
#pragma unroll
    for (int i = 0; i < 4; ++i) {
        const int idx = tid + i * 512, sr = idx >> 4, ch = idx & 15;
        const u32x4 raw = *(const u32x4*)(VG + (row0 + sr) * D + g * 128 + ch * 8);
        const float s1 = stats[(row0 + sr) * 2], s2 = stats[(row0 + sr) * 2 + 1];
        const float mean = s1 * (1.f / D), var = fmaxf(s2 * (1.f / D) - mean * mean, 0.f), rstd = 1.f / sqrtf(var + LN_EPS);
        const f32x4 g0 = *(const f32x4*)(lng + g * 128 + ch * 8), g1 = *(const f32x4*)(lng + g * 128 + ch * 8 + 4), b0 = *(const f32x4*)(lnb + g * 128 + ch * 8), b1 = *(const f32x4*)(lnb + g * 128 + ch * 8 + 4);
        f32x4 x0, x1; unpack8(raw, x0, x1);
        x0 = (x0 - mean) * rstd * g0 + b0; x1 = (x1 - mean) * rstd * g1 + b1;
        *(LAS u32x4*)(lds + sr * GROW + ch * 16) = pack8(x0, x1);
    }
    const int l15 = lane & 15, fq = lane >> 4, t = wid * 16 + l15;
    bf16x8 wf[4];
#pragma unroll
    for (int ks = 0; ks < 4; ++ks) wf[ks] = *(const bf16x8*)(WsB + ((size_t)g * 128 + t) * 128 + ks * 32 + fq * 8);
    __syncthreads();
    f32x4 acc[8];
#pragma unroll
    for (int cb = 0; cb < 8; ++cb) acc[cb] = (f32x4){0.f, 0.f, 0.f, 0.f};
    const int qq = l15 >> 2, pp = l15 & 3;
#pragma unroll
    for (int ks = 0; ks < 4; ++ks) {
        if (ks * 32 <= wid * 16 + 15) {
            LAS unsigned char* a0 = lds + (ks * 32 + 8 * fq + qq) * GROW + pp * 8;
#pragma unroll
            for (int cb = 0; cb < 8; ++cb) {
                const s16x4 lo = tr_read(a0 + cb * 32), hi = tr_read(a0 + 4 * GROW + cb * 32);
                const bf16x8 vf = {lo[0], lo[1], lo[2], lo[3], hi[0], hi[1], hi[2], hi[3]};
                acc[cb] = __builtin_amdgcn_mfma_f32_16x16x32_bf16(vf, wf[ks], acc[cb], 0, 0, 0);
            }
        }
    }
    const float bst = bs[g * 128 + t];
#pragma unroll
    for (int cb = 0; cb < 8; ++cb) {
        bf16_t* up = UY + (row0 + t) * D + g * 128 + cb * 16 + 4 * fq;
        const u32x2 uw = *(const u32x2*)up;
        u32x2 w; w.x = cvt_pk_bf16(bf_lo(uw.x) * (acc[cb][0] + bst), bf_hi(uw.x) * (acc[cb][1] + bst)); w.y = cvt_pk_bf16(bf_lo(uw.y) * (acc[cb][2] + bst), bf_hi(uw.y) * (acc[cb][3] + bst));
        *(u32x2*)up = w;
    }
    __syncthreads();
}

__device__ const float INV_FREQ[32] = {1.0f, 0.7498942613601685f, 0.5623413324356079f, 0.4216965138912201f, 0.3162277638912201f, 0.23713737726211548f, 0.17782793939113617f, 0.133352130651474f,
            0.10000000149011612f, 0.07498941570520401f, 0.05623413249850273f, 0.04216965287923813f, 0.03162277489900589f, 0.023713737726211548f, 0.017782794311642647f, 0.01333521492779255f,
            0.009999999776482582f, 0.007498941849917173f, 0.005623413249850273f, 0.0042169648222625256f, 0.003162277629598975f, 0.00237137358635664f, 0.0017782794311642647f, 0.0013335214462131262f,
            0.0010000000474974513f, 0.0007498942431993783f, 0.000562341301701963f, 0.0004216965171508491f, 0.0003162277571391314f, 0.00023713737027719617f, 0.00017782794020604342f, 0.0001333521504420787f};
__device__ __forceinline__ void gsync(cg::grid_group& grid) {
    asm volatile("s_waitcnt vmcnt(0)" ::: "memory");
    __syncthreads();
    if (threadIdx.x == 0) asm volatile("buffer_wbl2 sc1\n\ts_waitcnt vmcnt(0)" ::: "memory");
    grid.sync();
    if (threadIdx.x == 0) asm volatile("buffer_inv sc1\n\ts_waitcnt vmcnt(0)" ::: "memory");
    __syncthreads();
}
struct Args { const float* in[23]; const int* pos; float* out; unsigned char* ws; };

__global__ void __launch_bounds__(NWAVES * 64, 2) fwd_megakernel(Args a) {
    extern __shared__ __attribute__((aligned(16))) unsigned char lds_raw[];
    LAS unsigned char* lds = (LAS unsigned char*)lds_raw;
    cg::grid_group grid = cg::this_grid();
    const int tid = threadIdx.x, lane = tid & 63, wid = __builtin_amdgcn_readfirstlane(tid >> 6);
    const int G = gridDim.x, bx = blockIdx.x;
    const int gw = bx * NWAVES + wid, NGW = G * NWAVES;
    unsigned char* ws = a.ws;
    const float* x = a.in[0];
    bf16_t* Win_t = (bf16_t*)(ws + WS_WIN); bf16_t* Wa_t = (bf16_t*)(ws + WS_WA); bf16_t* Wg_t = (bf16_t*)(ws + WS_WG); bf16_t* Wo_t = (bf16_t*)(ws + WS_WO);
    bf16_t* W1gu_t = (bf16_t*)(ws + WS_W1GU); bf16_t* W1d_t = (bf16_t*)(ws + WS_W1D); bf16_t* W2gu_t = (bf16_t*)(ws + WS_W2GU); bf16_t* W2d_t = (bf16_t*)(ws + WS_W2D);
    float* cosT = (float*)(ws + WS_COS); float* sinT = (float*)(ws + WS_SIN); float* lse = (float*)(ws + WS_LSE); bf16_t* WsB = (bf16_t*)(ws + WS_WSB);
    float* stats = (float*)(ws + WS_STATS);
    bf16_t* XB = (bf16_t*)(ws + WS_XB); bf16_t* ACT1 = (bf16_t*)(ws + WS_ACT1); float* PRE1 = (float*)(ws + WS_PRE1);
    bf16_t* H1HI = (bf16_t*)a.out; bf16_t* H1LO = (bf16_t*)a.out + (size_t)M * D;
    bf16_t* Qb = (bf16_t*)(ws + WS_Q); bf16_t* Kb = (bf16_t*)(ws + WS_K); bf16_t* Vb = (bf16_t*)(ws + WS_V); bf16_t* Ub = (bf16_t*)(ws + WS_U); bf16_t* VGb = (bf16_t*)(ws + WS_VG);
    bf16_t* GATES = (bf16_t*)(ws + WS_GATES); bf16_t* YATT = (bf16_t*)(ws + WS_YATT); bf16_t* MRG = (bf16_t*)(ws + WS_MRG);
    float* PRE2 = (float*)(ws + WS_PRE2); bf16_t* H2B = (bf16_t*)(ws + WS_H2B); bf16_t* ACT2 = (bf16_t*)(ws + WS_ACT2);

    {
        LAS float* scr = (LAS float*)(lds + wid * 16384);
        constexpr int I_GU = 16 * 176, I_D = 44 * 32, I_IN = 16 * 272, I_A = 8 * 32, I_SQ = 16 * 32;
        constexpr int NITEMS = 2 * I_GU + 2 * I_D + I_IN + I_A + 2 * I_SQ;
        for (int it = gw; it < NITEMS; it += NGW) {
            int r = it;
            if (r < I_GU) { tr_gu(a.in[2], a.in[3], W1gu_t, r, scr, lane); continue; } r -= I_GU;
            if (r < I_D) { tr_plain(a.in[4], DFF, D, W1d_t, r, scr, lane); continue; } r -= I_D;
            if (r < I_IN) { tr_win(a.in[7], Win_t, r, scr, lane); continue; } r -= I_IN;
            if (r < I_A) { tr_plain(a.in[13], 512, D, Wa_t, r, scr, lane); continue; } r -= I_A;
            if (r < I_SQ) { tr_plain(a.in[14], D, D, Wg_t, r, scr, lane); continue; } r -= I_SQ;
            if (r < I_SQ) { tr_plain(a.in[15], D, D, Wo_t, r, scr, lane); continue; } r -= I_SQ;
            if (r < I_GU) { tr_gu(a.in[18], a.in[19], W2gu_t, r, scr, lane); continue; } r -= I_GU;
            tr_plain(a.in[20], DFF, D, W2d_t, r, scr, lane);
        }
        for (int m = gw; m < M; m += NGW) {
            const f32x4* xr = (const f32x4*)(x + (size_t)m * D) + lane; u32x2* o = (u32x2*)(XB + (size_t)m * D) + lane;
#pragma unroll
            for (int j = 0; j < 4; ++j) { const f32x4 v = xr[64 * j]; u32x2 w; w.x = pk2(v[0], v[1]); w.y = pk2(v[2], v[3]); o[64 * j] = w; }
        }
        const int gt = bx * (NWAVES * 64) + tid, NGT = G * NWAVES * 64;
        for (int e = gt; e < M * 32; e += NGT) {
            const int row = e >> 5, f = e & 31; const float ang = (float)a.pos[row] * INV_FREQ[f];
            float sv, cv; sincos_d(ang, sv, cv); cosT[e] = cv; sinT[e] = sv;
        }
        for (int e = gt; e < M * 2; e += NGT) stats[e] = 0.f;
        for (int e = gt; e < 8 * 128 * 128; e += NGT) { const int s = e & 127, t = (e >> 7) & 127; WsB[e] = (s <= t) ? (bf16_t)f2bf(a.in[11][e]) : (bf16_t)0; }
    }
    gsync(grid);

    { pg8::Gemm g{XB, W1gu_t, M, 2 * DFF, D}; pg8::StaticOrder S; S.init(M, 2 * DFF, G, bx); EpiSwiGLU E{ACT1};
      pg8::gemm_phase<EpiSwiGLU, pg8::StaticOrder, true, true>(lds, g, S, E); }
    gsync(grid);
    { pg8::Gemm g{ACT1, W1d_t, M, D, DFF}; pg8::StaticOrder S; S.init(M, D, G, bx); EpiResid E{x, PRE1, ALPHA, 0.5f};
      pg8::gemm_phase<EpiResid, pg8::StaticOrder, true, true>(lds, g, S, E); }
    gsync(grid);
    for (int m = gw; m < M; m += NGW) ln_row<0>(PRE1 + (size_t)m * D, a.in[5], a.in[6], nullptr, H1HI + (size_t)m * D, H1LO + (size_t)m * D, lane);
    gsync(grid);
    { pg8::Gemm g{H1HI, Win_t, M, 6656, D}; pg8::StaticOrder S; S.init(M, 6656, G, bx); EpiIn E{Qb, Kb, Vb, Ub, VGb, cosT, sinT, stats};
      pg8::gemm_phase<EpiIn, pg8::StaticOrder, true, true>(lds, g, S, E); }
    gsync(grid);
    for (int u = bx; u < 3072 + 1024; u += G) {
        if (u < 3072) attn_unit(lds, Qb, Kb, Vb, lse, u, tid, wid, lane);
        else gmlp_unit(lds, Ub, VGb, stats, a.in[9], a.in[10], WsB, a.in[12], u - 3072, tid, wid, lane);
    }
    gsync(grid);
    for (int m = gw; m < M; m += NGW) {
        const int h = lane >> 3, dc = lane & 7;
        const float l0 = lse[((size_t)0 * M + m) * 8 + h], l1 = lse[((size_t)1 * M + m) * 8 + h], l2 = lse[((size_t)2 * M + m) * 8 + h];
        const float mx = fmaxf(l0, fmaxf(l1, l2));
        float w0 = __builtin_amdgcn_exp2f(l0 - mx), w1 = __builtin_amdgcn_exp2f(l1 - mx), w2 = __builtin_amdgcn_exp2f(l2 - mx);
        const float inv = 1.f / (w0 + w1 + w2); w0 *= inv; w1 *= inv; w2 *= inv;
        const bf16_t* op = Qb + (size_t)m * AW + h * 64 + dc * 8;
        f32x4 a0, a1, b0, b1, c0, c1; unpack8(*(const u32x4*)op, a0, a1); unpack8(*(const u32x4*)(op + 512), b0, b1); unpack8(*(const u32x4*)(op + 1024), c0, c1);
        *(u32x4*)(YATT + (size_t)m * 512 + h * 64 + dc * 8) = pack8(a0 * w0 + b0 * w1 + c0 * w2, a1 * w0 + b1 * w1 + c1 * w2);
    }
    __syncthreads();
    { pg8::Gemm g{H1HI, Win_t + (size_t)6656 * D, M, 2048, D}; pg8::StaticOrder S; S.init(M, 2048, G, bx); EpiGate E{GATES, a.in[8]};
      pg8::gemm_phase<EpiGate, pg8::StaticOrder, true, true>(lds, g, S, E); }
    gsync(grid);
    { pg8::Gemm g{YATT, Wa_t, M, D, 512}; pg8::StaticOrder S; S.init(M, D, G, bx); EpiBranch<0> E{MRG, GATES, 0};
      pg8::gemm_phase<EpiBranch<0>, pg8::StaticOrder, true, true>(lds, g, S, E); }
    { pg8::Gemm g{Ub, Wg_t, M, D, D}; pg8::StaticOrder S; S.init(M, D, G, bx); EpiBranch<1> E{MRG, GATES, 1024};
      pg8::gemm_phase<EpiBranch<1>, pg8::StaticOrder, true, true>(lds, g, S, E); }
    gsync(grid);
    { pg8::Gemm g{MRG, Wo_t, M, D, D}; pg8::StaticOrder S; S.init(M, D, G, bx); EpiResidHL E{H1HI, H1LO, PRE2, ALPHA};
      pg8::gemm_phase<EpiResidHL, pg8::StaticOrder, true, true>(lds, g, S, E); }
    gsync(grid);
    for (int m = gw; m < M; m += NGW) ln_row<1>(PRE2 + (size_t)m * D, a.in[16], a.in[17], PRE2 + (size_t)m * D, H2B + (size_t)m * D, nullptr, lane);
    gsync(grid);
    { pg8::Gemm g{H2B, W2gu_t, M, 2 * DFF, D}; pg8::StaticOrder S; S.init(M, 2 * DFF, G, bx); EpiSwiGLU E{ACT2};
      pg8::gemm_phase<EpiSwiGLU, pg8::StaticOrder, true, true>(lds, g, S, E); }
    gsync(grid);
    { pg8::Gemm g{ACT2, W2d_t, M, D, DFF}; pg8::StaticOrder S; S.init(M, D, G, bx); EpiResid E{PRE2, a.out, ALPHA, 0.5f};
      pg8::gemm_phase<EpiResid, pg8::StaticOrder, true, true>(lds, g, S, E); }
    gsync(grid);
    for (int m = gw; m < M; m += NGW) ln_row<2>(a.out + (size_t)m * D, a.in[21], a.in[22], a.out + (size_t)m * D, nullptr, nullptr, lane);
}

extern "C" void kernel_launch(void* const* d_in, const int* in_sizes, int n_in, void* d_out, int out_size, void* d_ws, size_t ws_size, hipStream_t stream) {
    static int grid = 0;
    if (grid == 0) {
        if (n_in != 23 || in_sizes[0] != M * D || out_size != M * D || ws_size < WS_END) { fprintf(stderr, "kernel_launch: unexpected shapes (n_in %d, in0 %d, out %d, ws %zu)\n", n_in, n_in > 0 ? in_sizes[0] : -1, out_size, ws_size); grid = -1; return; }
        int dev = 0, cus = 0, per_cu = 0;
        if (hipGetDevice(&dev) != hipSuccess || hipDeviceGetAttribute(&cus, hipDeviceAttributeMultiprocessorCount, dev) != hipSuccess) { grid = -1; return; }
        if (hipFuncSetAttribute((const void*)fwd_megakernel, hipFuncAttributeMaxDynamicSharedMemorySize, LDS_BYTES) != hipSuccess) { fprintf(stderr, "kernel_launch: hipFuncSetAttribute failed\n"); grid = -1; return; }
        if (hipOccupancyMaxActiveBlocksPerMultiprocessor(&per_cu, (const void*)fwd_megakernel, NWAVES * 64, LDS_BYTES) != hipSuccess || per_cu < 1) per_cu = 1;
        (void)hipGetLastError();
        grid = cus;
    }
    if (grid < 0) return;
    Args a{};
    for (int i = 0; i < 23; ++i) a.in[i] = (const float*)d_in[i];
    a.pos = (const int*)d_in[1]; a.out = (float*)d_out; a.ws = (unsigned char*)d_ws;
    void* args[] = {&a};
    hipError_t e = hipLaunchCooperativeKernel((const void*)fwd_megakernel, dim3(grid), dim3(NWAVES * 64), args, LDS_BYTES, stream);
    if (e != hipSuccess) fprintf(stderr, "kernel_launch: cooperative launch failed: %s (grid %d)\n", hipGetErrorString(e), grid);
}
```

```cpp
#include <hip/hip_runtime.h>
#include <hip/hip_cooperative_groups.h>
#include <cstdio>
#include <cstdint>
#include <cmath>
namespace pg8 {
#define PG8_LAS __attribute__((address_space(3)))
typedef unsigned short bf16_t;
typedef short bf16x8 __attribute__((ext_vector_type(8)));
typedef float f32x4 __attribute__((ext_vector_type(4)));
typedef unsigned u32x4 __attribute__((ext_vector_type(4)));
constexpr int BM = 256, BK = 64, HALF = 128, HTB = HALF * BK * 2  , STAGE_BYTES = 8 * HTB, NXCD = 8, WGM = 8;

__host__ __device__ __forceinline__ int lds_byte(int r, int c) { const int st = (r >> 4) * 2 + (c >> 5), rr = r & 15, cc = c & 31, ob = rr * 64 + cc * 2; return st * 1024 + (ob ^ (((ob >> 9) & 1) << 5)); }
__host__ __device__ __forceinline__ void stage_rc(int b, int& R, int& C) { const int st = b / 1024, sb = b % 1024, swz = sb ^ (((sb >> 9) & 1) << 5); R = (st >> 1) * 16 + swz / 64; C = (st & 1) * 32 + (swz % 64) / 2; }
__host__ __device__ __forceinline__ int perm32(int rho) { const int n = rho >> 4, i = rho & 15; return 8 * (i >> 2) + 4 * n + (i & 3); }

struct Unit { int pm, pn; };
struct Gemm { const bf16_t* A; const bf16_t* Bt; int M, N, K; };

struct StaticOrder {
    int nM, nN, nwg, G, c;
    __host__ __device__ void init(int M, int N, int G_, int c_) { nM = M / BM; nN = N / BM; nwg = nM * nN; G = G_; c = c_; }
    __host__ __device__ bool next(int i, Unit& u) const {
        const long L = (long)i * G + c; if (L >= nwg) return false;
        int wgid = (int)L; { const int q = nwg / NXCD, r = nwg % NXCD, xcd = wgid % NXCD, off = wgid / NXCD; wgid = (xcd < r ? xcd * (q + 1) : r * (q + 1) + (xcd - r) * q) + off; }
        const int nig = WGM * nN, gid = wgid / nig, fm = gid * WGM, gsz = (nM - fm) < WGM ? (nM - fm) : WGM;
        u.pm = fm + ((wgid % nig) % gsz); u.pn = (wgid % nig) / gsz; return true;
    }
    __device__ __forceinline__ void a_ready(const Unit&) const {}
    __device__ __forceinline__ void done(const Unit&) const {}
};

__device__ __forceinline__ unsigned cvt_pk_bf16(float lo, float hi) { unsigned r; asm volatile("v_cvt_pk_bf16_f32 %0, %1, %2" : "=v"(r) : "v"(lo), "v"(hi)); return r; }
typedef float f32x2 __attribute__((ext_vector_type(2)));
__device__ __forceinline__ f32x2 gelu_pk(f32x2 v) {
    const f32x2 av = __builtin_elementwise_abs(v), d = av * 0.2316418882f + 1.0f;
    f32x2 t; t.x = __builtin_amdgcn_rcpf(d.x); t.y = __builtin_amdgcn_rcpf(d.y);
    f32x2 q = t * 0.5307027145f + (-0.7265760135f); q = q * t + 0.7107068705f; q = q * t + (-0.142248368f); q = q * t + 0.127414796f; q = q * t;
    const f32x2 s = (v * v) * (-0.72134752044f);
    f32x2 e; e.x = __builtin_amdgcn_exp2f(s.x); e.y = __builtin_amdgcn_exp2f(s.y);
    const f32x2 m = v * (q * e), r = v - m;
    f32x2 o; o.x = v.x < 0.f ? m.x : r.x; o.y = v.y < 0.f ? m.y : r.y; return o;
}
template <class Epi, class Sched, bool ALIGN_EPI = false, bool SP2 = false>
__device__ __forceinline__ void gemm_phase(PG8_LAS unsigned char* lds, const Gemm g, const Sched& S, const Epi& E) {
    const int tid = threadIdx.x, wid = __builtin_amdgcn_readfirstlane(tid >> 6), lane = tid & 63, wr = wid >> 2, wc = wid & 3, fr = lane & 15, fq = lane >> 4;
    const int K = g.K, nt = K / BK;
    unsigned voffA[2], voffB[2];
#pragma unroll
    for (int i = 0; i < 2; ++i) { int R, C; stage_rc(tid * 16 + i * 8192, R, C); const int Rb = Epi::PERM ? ((R & ~31) + perm32(R & 31)) : R;
        voffA[i] = (unsigned)(R * K + C) * 2u; voffB[i] = (unsigned)(Rb * K + C) * 2u; }
    const size_t kstep = (size_t)(BK * 2);
    const size_t hstep = (size_t)HALF * K * 2;
    const size_t tstep = 2 * hstep;
    const unsigned ldsw = (unsigned)wid * 1024u;
    const int aoff = lds_byte(wr * 64 + fr, fq * 8), boff = lds_byte(wc * 32 + fr, fq * 8);
#define PG8_SA(b, h) (((b) * 2 + (h)) * HTB)
#define PG8_SB(b, h) ((4 + (b) * 2 + (h)) * HTB)
#define PG8_STAGE(bufoff, gbase, voff) do { _Pragma("unroll") for (int _i = 0; _i < 2; ++_i) \
        __builtin_amdgcn_global_load_lds((const unsigned*)((const char*)(gbase) + (voff)[_i]), (PG8_LAS unsigned*)(lds + (bufoff) + ldsw + _i * 8192), 16, 0, 0); } while (0)
#define PG8_LDA(dst, b, h) do { _Pragma("unroll") for (int m = 0; m < 4; ++m) _Pragma("unroll") for (int k = 0; k < 2; ++k) dst[m][k] = *(const PG8_LAS bf16x8*)(lds + PG8_SA(b, h) + aoff + m * 2048 + k * 1024); } while (0)
#define PG8_LDB(dst, b, h) do { _Pragma("unroll") for (int n = 0; n < 2; ++n) _Pragma("unroll") for (int k = 0; k < 2; ++k) dst[n][k] = *(const PG8_LAS bf16x8*)(lds + PG8_SB(b, h) + boff + n * 2048 + k * 1024); } while (0)
#define PG8_MMA(ai, bj, At, Bt) do { __builtin_amdgcn_s_setprio(1); _Pragma("unroll") for (int m = 0; m < 4; ++m) _Pragma("unroll") for (int n = 0; n < 2; ++n) _Pragma("unroll") for (int k = 0; k < 2; ++k) \
        acc[ai][bj][m][n] = __builtin_amdgcn_mfma_f32_16x16x32_bf16(Bt[n][k], At[m][k], acc[ai][bj][m][n], 0, 0, 0); __builtin_amdgcn_s_setprio(0); } while (0)
#define PG8_WAIT_V(n) asm volatile("s_waitcnt vmcnt(" #n ")" ::: "memory")
#define PG8_WAIT_L(n) asm volatile("s_waitcnt lgkmcnt(" #n ")" ::: "memory")
#define PG8_BAR __builtin_amdgcn_s_barrier()
#define PG8_SCHED __builtin_amdgcn_sched_barrier(0)
    Unit cur, nxt; int ui = 0;
    if (!S.next(0, cur)) return;
    f32x4 acc[2][2][4][2];
#pragma unroll
    for (int a = 0; a < 2; ++a)
#pragma unroll
        for (int b = 0; b < 2; ++b)
#pragma unroll
            for (int m = 0; m < 4; ++m)
#pragma unroll
                for (int n = 0; n < 2; ++n) acc[a][b][m][n] = (f32x4){0.f, 0.f, 0.f, 0.f};
    bf16x8 At[4][2], B0[2][2], B1[2][2];
    const char* cA = (const char*)g.A + (size_t)cur.pm * tstep; const char* cB = (const char*)g.Bt + (size_t)cur.pn * tstep;
    S.a_ready(cur);
    if constexpr (SP2) {
        PG8_STAGE(PG8_SB(0, 0), cB, voffB); PG8_STAGE(PG8_SB(0, 1), cB + hstep, voffB); PG8_STAGE(PG8_SA(0, 0), cA, voffA); PG8_STAGE(PG8_SA(0, 1), cA + hstep, voffA);
        if (wr == 1) PG8_BAR;
        PG8_WAIT_V(2); PG8_BAR;
        PG8_STAGE(PG8_SB(1, 0), cB + kstep, voffB); PG8_STAGE(PG8_SA(1, 0), cA + kstep, voffA); PG8_STAGE(PG8_SB(1, 1), cB + hstep + kstep, voffB);
        PG8_WAIT_V(6); PG8_BAR;
    } else {
        PG8_STAGE(PG8_SB(0, 0), cB, voffB); PG8_STAGE(PG8_SA(0, 0), cA, voffA); PG8_STAGE(PG8_SB(0, 1), cB + hstep, voffB); PG8_STAGE(PG8_SA(0, 1), cA + hstep, voffA);
        if (wr == 1) PG8_BAR;
        PG8_WAIT_V(4); PG8_BAR;
        PG8_STAGE(PG8_SB(1, 0), cB + kstep, voffB); PG8_STAGE(PG8_SA(1, 0), cA + kstep, voffA); PG8_STAGE(PG8_SB(1, 1), cB + hstep + kstep, voffB);
        PG8_WAIT_V(6); PG8_BAR;
    }
    for (;;) {
        const bool has_next = S.next(ui + 1, nxt);
        const char* nA = has_next ? (const char*)g.A + (size_t)nxt.pm * tstep : cA; const char* nB = has_next ? (const char*)g.Bt + (size_t)nxt.pn * tstep : cB;
        for (int t = 0; t < nt; t += 2) {
            const bool last = (t == nt - 2);
            const char* a1 = cA + (size_t)(t + 1) * kstep;
            const char* a2 = last ? nA : cA + (size_t)(t + 2) * kstep; const char* b2 = last ? nB : cB + (size_t)(t + 2) * kstep;
            const char* a3 = a2 + kstep; const char* b3 = b2 + kstep;
            if (last && has_next) S.a_ready(nxt);
            if constexpr (SP2) {
            PG8_LDB(B0, 0, 0); PG8_LDB(B1, 0, 1); PG8_SCHED; PG8_LDA(At, 0, 0); PG8_STAGE(PG8_SA(1, 1), a1 + hstep, voffA);
            PG8_WAIT_V(8); PG8_WAIT_L(0); PG8_BAR; PG8_MMA(0, 0, At, B0); PG8_MMA(0, 1, At, B1); PG8_BAR; PG8_SCHED;
            PG8_LDA(At, 0, 1); PG8_STAGE(PG8_SB(0, 0), b2, voffB); PG8_STAGE(PG8_SB(0, 1), b2 + hstep, voffB); PG8_STAGE(PG8_SA(0, 0), a2, voffA);
            PG8_WAIT_V(8); PG8_WAIT_L(0); PG8_BAR; PG8_MMA(1, 0, At, B0); PG8_MMA(1, 1, At, B1); PG8_BAR; PG8_SCHED;
            PG8_LDB(B0, 1, 0); PG8_LDB(B1, 1, 1); PG8_SCHED; PG8_LDA(At, 1, 0); PG8_STAGE(PG8_SA(0, 1), a2 + hstep, voffA);
            PG8_WAIT_V(8); PG8_WAIT_L(0); PG8_BAR; PG8_MMA(0, 0, At, B0); PG8_MMA(0, 1, At, B1); PG8_BAR; PG8_SCHED;
            PG8_LDA(At, 1, 1); PG8_STAGE(PG8_SB(1, 0), b3, voffB); PG8_STAGE(PG8_SB(1, 1), b3 + hstep, voffB); PG8_STAGE(PG8_SA(1, 0), a3, voffA);
            PG8_WAIT_V(8); PG8_WAIT_L(0); PG8_BAR; PG8_MMA(1, 0, At, B0); PG8_MMA(1, 1, At, B1); PG8_BAR; PG8_SCHED;
            } else {
            PG8_LDB(B0, 0, 0); PG8_SCHED; PG8_LDA(At, 0, 0); PG8_STAGE(PG8_SA(1, 1), a1 + hstep, voffA);
            PG8_WAIT_L(8); PG8_BAR; PG8_WAIT_L(0); PG8_MMA(0, 0, At, B0); PG8_BAR; PG8_SCHED;
            PG8_LDB(B1, 0, 1); PG8_STAGE(PG8_SB(0, 0), b2, voffB);
            PG8_BAR; PG8_WAIT_L(0); PG8_MMA(0, 1, At, B1); PG8_BAR;
            PG8_LDA(At, 0, 1); PG8_STAGE(PG8_SA(0, 0), a2, voffA);
            PG8_BAR; PG8_WAIT_L(0); PG8_MMA(1, 0, At, B0); PG8_BAR; PG8_SCHED;
            PG8_STAGE(PG8_SB(0, 1), b2 + hstep, voffB);
            PG8_WAIT_V(6); PG8_BAR; PG8_MMA(1, 1, At, B1); PG8_BAR;
            PG8_LDB(B0, 1, 0); PG8_SCHED; PG8_LDA(At, 1, 0); PG8_STAGE(PG8_SA(0, 1), a2 + hstep, voffA);
            PG8_WAIT_L(8); PG8_BAR; PG8_WAIT_L(0); PG8_MMA(0, 0, At, B0); PG8_BAR; PG8_SCHED;
            PG8_LDB(B1, 1, 1); PG8_STAGE(PG8_SB(1, 0), b3, voffB);
            PG8_BAR; PG8_WAIT_L(0); PG8_MMA(0, 1, At, B1); PG8_BAR;
            PG8_LDA(At, 1, 1); PG8_STAGE(PG8_SA(1, 0), a3, voffA);
            PG8_BAR; PG8_WAIT_L(0); PG8_MMA(1, 0, At, B0); PG8_BAR; PG8_SCHED;
            PG8_STAGE(PG8_SB(1, 1), b3 + hstep, voffB);
            PG8_WAIT_V(6); PG8_BAR; PG8_MMA(1, 1, At, B1); PG8_BAR;
            }
        }
        if constexpr (ALIGN_EPI) { if (wr == 0) PG8_BAR; }
        if constexpr (!Epi::AFTER_DRAIN) { E(acc, cur, wr, wc, fr, fq); S.done(cur); }
        if (!has_next) break;
#pragma unroll
        for (int a = 0; a < 2; ++a)
#pragma unroll
            for (int b = 0; b < 2; ++b)
#pragma unroll
                for (int m = 0; m < 4; ++m)
#pragma unroll
                    for (int n = 0; n < 2; ++n) acc[a][b][m][n] = (f32x4){0.f, 0.f, 0.f, 0.f};
        cur = nxt; cA = nA; cB = nB; ++ui;
        if constexpr (ALIGN_EPI) { if (wr == 1) PG8_BAR; }
    }
    PG8_WAIT_V(0);
    if constexpr (!ALIGN_EPI) { if (wr == 0) PG8_BAR; }
    PG8_BAR;
    if constexpr (Epi::AFTER_DRAIN) { E.fused(acc, cur, wr, wc, fr, fq, lds, wid, lane); S.done(cur); }
#undef PG8_SA
#undef PG8_SB
#undef PG8_STAGE
#undef PG8_LDA
#undef PG8_LDB
#undef PG8_MMA
#undef PG8_WAIT_V
#undef PG8_WAIT_L
#undef PG8_BAR
#undef PG8_SCHED
}
}

namespace cg = cooperative_groups;
#define LAS __attribute__((address_space(3)))
using pg8::bf16_t; using pg8::bf16x8; using pg8::f32x4; using pg8::u32x4; using pg8::Unit;
typedef float f32x2_t __attribute__((ext_vector_type(2))); typedef __bf16 bf16x2_t __attribute__((ext_vector_type(2)));
__device__ __forceinline__ unsigned cvt_pk_bf16(float lo, float hi) { f32x2_t v = {lo, hi}; bf16x2_t b = __builtin_convertvector(v, bf16x2_t); return __builtin_bit_cast(unsigned, b); }
typedef unsigned u32x2 __attribute__((ext_vector_type(2)));
typedef short s16x4 __attribute__((ext_vector_type(4)));

constexpr int M = 16384, D = 1024, SEQ = 2048, DFF = 2816, AW = 1536, NWAVES = 8, NIN = 8704;
constexpr float ALPHA = 1.189207115002721f;
constexpr float LN_EPS = 1e-5f;
constexpr float QSCALE = 0.125f * 1.4426950408889634f;

constexpr size_t MiB = 1u << 20;
constexpr size_t WS_STATS = 0;
constexpr size_t WS_WIN = 1 * MiB, WS_WA = 18 * MiB, WS_WG = 19 * MiB, WS_WO = 21 * MiB, WS_W2GU = 23 * MiB, WS_W2D = 34 * MiB;
constexpr size_t WS_COS = 40 * MiB, WS_SIN = 42 * MiB, WS_LSE = 44 * MiB, WS_WSB = 45 * MiB + 512 * 1024;
constexpr size_t WS_W1GU = 46 * MiB, WS_W1D = 57 * MiB;
constexpr size_t WS_XB = 64 * MiB, WS_ACT1 = 96 * MiB, WS_PRE1 = 184 * MiB;
constexpr size_t WS_Q = 46 * MiB, WS_K = 94 * MiB, WS_V = 142 * MiB, WS_U = 190 * MiB, WS_VG = 222 * MiB;
constexpr size_t WS_GATES = 94 * MiB, WS_YATT = 158 * MiB, WS_MRG = 222 * MiB;
constexpr size_t WS_PRE2 = 94 * MiB, WS_H2B = 46 * MiB, WS_ACT2 = 160 * MiB;
constexpr size_t WS_END = 256 * MiB;
constexpr int LDS_BYTES = 135168;

__device__ __forceinline__ float bf_lo(unsigned w) { return __uint_as_float(w << 16); }
__device__ __forceinline__ float bf_hi(unsigned w) { return __uint_as_float(w & 0xffff0000u); }
__device__ __forceinline__ float fast_rcp(float x) { return __builtin_amdgcn_rcpf(x); }
__device__ __forceinline__ float sigmoidf_(float x) { return fast_rcp(1.f + __builtin_amdgcn_exp2f(-1.4426950408889634f * x)); }
__device__ __forceinline__ float wave_sum(float v) {
#pragma unroll
    for (int o = 1; o < 64; o <<= 1) v += __shfl_xor(v, o);
    return v;
}
__device__ __forceinline__ u32x4 pack8(const f32x4 a, const f32x4 b) {
    u32x4 w; w.x = cvt_pk_bf16(a[0], a[1]); w.y = cvt_pk_bf16(a[2], a[3]); w.z = cvt_pk_bf16(b[0], b[1]); w.w = cvt_pk_bf16(b[2], b[3]); return w;
}
__device__ __forceinline__ void unpack8(const u32x4 w, f32x4& a, f32x4& b) {
    a = (f32x4){bf_lo(w.x), bf_hi(w.x), bf_lo(w.y), bf_hi(w.y)}; b = (f32x4){bf_lo(w.z), bf_hi(w.z), bf_lo(w.w), bf_hi(w.w)};
}


struct EpiSwiGLU {
    static constexpr bool PERM = true, AFTER_DRAIN = false;
    bf16_t* O;
    __device__ __forceinline__ void operator()(const f32x4 (&acc)[2][2][4][2], const Unit& u, int wr, int wc, int fr, int fq) const {
        const int row0 = u.pm * 256 + wr * 64 + fr, col0 = u.pn * 128 + wc * 32 + 8 * fq;
#pragma unroll
        for (int ai = 0; ai < 2; ++ai)
#pragma unroll
            for (int m = 0; m < 4; ++m) {
                f32x4 o[2];
#pragma unroll
                for (int n = 0; n < 2; ++n) {
                    const f32x4 g = acc[ai][0][m][n], up = acc[ai][1][m][n];
#pragma unroll
                    for (int j = 0; j < 4; ++j) o[n][j] = g[j] * sigmoidf_(g[j]) * up[j];
                }
                *(u32x4*)(O + (size_t)(row0 + ai * 128 + m * 16) * DFF + col0) = pack8(o[0], o[1]);
            }
    }
};
struct EpiResid {
    static constexpr bool PERM = true, AFTER_DRAIN = false;
    const float* R; float* O; float alpha, scale;
    __device__ __forceinline__ void operator()(const f32x4 (&acc)[2][2][4][2], const Unit& u, int wr, int wc, int fr, int fq) const {
        const int row0 = u.pm * 256 + wr * 64 + fr, col0 = u.pn * 256 + wc * 32 + 8 * fq;
#pragma unroll
        for (int ai = 0; ai < 2; ++ai)
#pragma unroll
            for (int m = 0; m < 4; ++m)
#pragma unroll
                for (int bj = 0; bj < 2; ++bj) {
                    const size_t off = (size_t)(row0 + ai * 128 + m * 16) * D + col0 + bj * 128;
                    const f32x4 r0 = *(const f32x4*)(R + off), r1 = *(const f32x4*)(R + off + 4);
                    *(f32x4*)(O + off) = r0 * alpha + acc[ai][bj][m][0] * scale;
                    *(f32x4*)(O + off + 4) = r1 * alpha + acc[ai][bj][m][1] * scale;
                }
    }
};
struct EpiResidHL {
    static constexpr bool PERM = true, AFTER_DRAIN = false;
    const bf16_t* Rhi; const bf16_t* Rlo; float* O; float alpha;
    __device__ __forceinline__ void operator()(const f32x4 (&acc)[2][2][4][2], const Unit& u, int wr, int wc, int fr, int fq) const {
        const int row0 = u.pm * 256 + wr * 64 + fr, col0 = u.pn * 256 + wc * 32 + 8 * fq;
#pragma unroll
        for (int ai = 0; ai < 2; ++ai)
#pragma unroll
            for (int m = 0; m < 4; ++m)
#pragma unroll
                for (int bj = 0; bj < 2; ++bj) {
                    const size_t off = (size_t)(row0 + ai * 128 + m * 16) * D + col0 + bj * 128;
                    f32x4 h0, h1, l0, l1; unpack8(*(const u32x4*)(Rhi + off), h0, h1); unpack8(*(const u32x4*)(Rlo + off), l0, l1);
                    *(f32x4*)(O + off) = (h0 + l0) * alpha + acc[ai][bj][m][0];
                    *(f32x4*)(O + off + 4) = (h1 + l1) * alpha + acc[ai][bj][m][1];
                }
    }
};
struct EpiGate {
    static constexpr bool PERM = true, AFTER_DRAIN = false;
    bf16_t* O; const float* bias;
    __device__ __forceinline__ void operator()(const f32x4 (&acc)[2][2][4][2], const Unit& u, int wr, int wc, int fr, int fq) const {
        const int row0 = u.pm * 256 + wr * 64 + fr, col0 = u.pn * 256 + wc * 32 + 8 * fq;
#pragma unroll
        for (int bj = 0; bj < 2; ++bj) {
            const f32x4 b0 = *(const f32x4*)(bias + col0 + bj * 128), b1 = *(const f32x4*)(bias + col0 + bj * 128 + 4);
#pragma unroll
            for (int ai = 0; ai < 2; ++ai)
#pragma unroll
                for (int m = 0; m < 4; ++m) {
                    f32x4 o0 = acc[ai][bj][m][0] + b0, o1 = acc[ai][bj][m][1] + b1;
#pragma unroll
                    for (int j = 0; j < 4; ++j) { o0[j] = sigmoidf_(o0[j]); o1[j] = sigmoidf_(o1[j]); }
                    *(u32x4*)(O + (size_t)(row0 + ai * 128 + m * 16) * 2048 + col0 + bj * 128) = pack8(o0, o1);
                }
        }
    }
};
template <int MODE> struct EpiBranch {
    static constexpr bool PERM = true, AFTER_DRAIN = false;
    bf16_t* T; const bf16_t* G; int goff;
    __device__ __forceinline__ void operator()(const f32x4 (&acc)[2][2][4][2], const Unit& u, int wr, int wc, int fr, int fq) const {
        const int row0 = u.pm * 256 + wr * 64 + fr, col0 = u.pn * 256 + wc * 32 + 8 * fq;
#pragma unroll
        for (int ai = 0; ai < 2; ++ai)
#pragma unroll
            for (int m = 0; m < 4; ++m)
#pragma unroll
                for (int bj = 0; bj < 2; ++bj) {
                    const size_t row = (size_t)(row0 + ai * 128 + m * 16);
                    f32x4 g0, g1; unpack8(*(const u32x4*)(G + row * 2048 + goff + col0 + bj * 128), g0, g1);
                    f32x4 o0 = g0 * acc[ai][bj][m][0], o1 = g1 * acc[ai][bj][m][1];
                    bf16_t* tp = T + row * D + col0 + bj * 128;
                    if (MODE == 1) { f32x4 t0, t1; unpack8(*(const u32x4*)tp, t0, t1); o0 += t0; o1 += t1; }
                    *(u32x4*)tp = pack8(o0, o1);
                }
    }
};
struct EpiIn {
    static constexpr bool PERM = true, AFTER_DRAIN = false;
    bf16_t *Q, *K, *V, *U, *VG; const float* cosT; const float* sinT; float* stats;
    __device__ __forceinline__ void operator()(const f32x4 (&acc)[2][2][4][2], const Unit& u, int wr, int wc, int fr, int fq) const {
        const int row0 = u.pm * 256 + wr * 64 + fr, pn = u.pn;
        if (pn < 12) {
            bf16_t* dst = pn < 6 ? Q : K; const float sc = pn < 6 ? QSCALE : 1.f; const int cb = 256 * (pn < 6 ? pn : pn - 6) + 64 * wc + 8 * fq;
#pragma unroll
            for (int ai = 0; ai < 2; ++ai)
#pragma unroll
                for (int m = 0; m < 4; ++m) {
                    const size_t row = (size_t)(row0 + ai * 128 + m * 16);
                    f32x4 o1[2], o2[2];
#pragma unroll
                    for (int n = 0; n < 2; ++n) {
                        const f32x4 c = *(const f32x4*)(cosT + row * 32 + 8 * fq + 4 * n) * sc, s = *(const f32x4*)(sinT + row * 32 + 8 * fq + 4 * n) * sc;
                        const f32x4 t1 = acc[ai][0][m][n], t2 = acc[ai][1][m][n];
                        o1[n] = t1 * c - t2 * s; o2[n] = t2 * c + t1 * s;
                    }
                    *(u32x4*)(dst + row * AW + cb) = pack8(o1[0], o1[1]);
                    *(u32x4*)(dst + row * AW + cb + 32) = pack8(o2[0], o2[1]);
                }
        } else if (pn < 18) {
            const int cb = 256 * (pn - 12) + 32 * wc + 8 * fq;
#pragma unroll
            for (int ai = 0; ai < 2; ++ai)
#pragma unroll
                for (int m = 0; m < 4; ++m)
#pragma unroll
                    for (int bj = 0; bj < 2; ++bj)
                        *(u32x4*)(V + (size_t)(row0 + ai * 128 + m * 16) * AW + cb + bj * 128) = pack8(acc[ai][bj][m][0], acc[ai][bj][m][1]);
        } else {
            const bool isvg = pn >= 22; bf16_t* dst = isvg ? VG : U; const int cb = 256 * ((pn - 18) & 3) + 32 * wc + 8 * fq;
#pragma unroll
            for (int ai = 0; ai < 2; ++ai)
#pragma unroll
                for (int m = 0; m < 4; ++m) {
                    const size_t row = (size_t)(row0 + ai * 128 + m * 16);
                    float s1 = 0.f, s2 = 0.f;
#pragma unroll
                    for (int bj = 0; bj < 2; ++bj) {
                        const f32x4 a = acc[ai][bj][m][0], b = acc[ai][bj][m][1];
                        const pg8::f32x2 g0 = pg8::gelu_pk((pg8::f32x2){a[0], a[1]}), g1 = pg8::gelu_pk((pg8::f32x2){a[2], a[3]}), g2 = pg8::gelu_pk((pg8::f32x2){b[0], b[1]}), g3 = pg8::gelu_pk((pg8::f32x2){b[2], b[3]});
                        u32x4 w; w.x = cvt_pk_bf16(g0.x, g0.y); w.y = cvt_pk_bf16(g1.x, g1.y); w.z = cvt_pk_bf16(g2.x, g2.y); w.w = cvt_pk_bf16(g3.x, g3.y);
                        *(u32x4*)(dst + row * D + cb + bj * 128) = w;
                        s1 += (g0.x + g0.y) + (g1.x + g1.y) + (g2.x + g2.y) + (g3.x + g3.y);
                        s2 += (g0.x * g0.x + g0.y * g0.y) + (g1.x * g1.x + g1.y * g1.y) + (g2.x * g2.x + g2.y * g2.y) + (g3.x * g3.x + g3.y * g3.y);
                    }
                    if (isvg) {
                        s1 += __shfl_xor(s1, 16); s1 += __shfl_xor(s1, 32); s2 += __shfl_xor(s2, 16); s2 += __shfl_xor(s2, 32);
                        if (fq == 0) { atomicAdd(stats + row * 2, s1); atomicAdd(stats + row * 2 + 1, s2); }
                    }
                }
        }
    }
};

__device__ __forceinline__ unsigned f2bf(float f) { unsigned u = __builtin_bit_cast(unsigned, f); return (u + 0x7fffu + ((u >> 16) & 1u)) >> 16; }
__device__ __forceinline__ unsigned pk2(float lo, float hi) { return f2bf(lo) | (f2bf(hi) << 16); }

__device__ __forceinline__ void tr_item(const float* W, int ldN, int ncol0, int k0, bf16_t* WT, int K, int prow0, LAS float* scr, int lane) {
#pragma unroll 8
    for (int i = 0; i < 32; ++i) { const int kk = 2 * i + (lane >> 5); scr[kk * 33 + (lane & 31)] = W[(size_t)(k0 + kk) * ldN + ncol0 + (lane & 31)]; }
    asm volatile("s_waitcnt lgkmcnt(0)" ::: "memory");
    const int c = lane & 7;
#pragma unroll
    for (int j = 0; j < 4; ++j) { const int n = (lane >> 3) + 8 * j; const LAS float* s = scr + (8 * c) * 33 + n;
        u32x4 o; o.x = pk2(s[0 * 33], s[1 * 33]); o.y = pk2(s[2 * 33], s[3 * 33]); o.z = pk2(s[4 * 33], s[5 * 33]); o.w = pk2(s[6 * 33], s[7 * 33]);
        *(u32x4*)(WT + (size_t)(prow0 + n) * K + k0 + 8 * c) = o; }
    asm volatile("s_waitcnt lgkmcnt(0)" ::: "memory");
}
__device__ __forceinline__ void tr_plain(const float* W, int K, int N, bf16_t* WT, int item, LAS float* scr, int lane) {
    const int nblk = N / 32, kb = item / nblk, nb = item % nblk; tr_item(W, N, 32 * nb, 64 * kb, WT, K, 32 * nb, scr, lane);
}
__device__ __forceinline__ void tr_gu(const float* Wg, const float* Wu, bf16_t* WT, int item, LAS float* scr, int lane) {
    const int nblk = (2 * DFF) / 32, kb = item / nblk, nb = item % nblk, p0 = 32 * nb, tile = p0 >> 8, bj = (p0 >> 7) & 1, x = p0 & 127;
    tr_item(bj ? Wu : Wg, DFF, 128 * tile + x, 64 * kb, WT, D, p0, scr, lane);
}
__device__ __forceinline__ void tr_win(const float* W, bf16_t* WT, int item, LAS float* scr, int lane) {
    const int nblk = NIN / 32, kb = item / nblk, nb = item % nblk, p0 = 32 * nb;
    int nc = p0; if (p0 < 3072) { const int tile = p0 >> 8, bj = (p0 >> 7) & 1, wc = (p0 >> 5) & 3; nc = 256 * tile + 64 * wc + 32 * bj; }
    tr_item(W, NIN, nc, 64 * kb, WT, D, p0, scr, lane);
}

template <int MODE> __device__ __forceinline__ void ln_row(const float* xrow, const float* gam, const float* bet, float* of32, bf16_t* ob0, bf16_t* ob1, int lane) {
    const f32x4* xr = (const f32x4*)xrow + lane;
    f32x4 v[4]; float s = 0.f;
#pragma unroll
    for (int j = 0; j < 4; ++j) { v[j] = xr[64 * j]; s += (v[j][0] + v[j][1]) + (v[j][2] + v[j][3]); }
    const float mean = wave_sum(s) * (1.f / D); float s2 = 0.f;
#pragma unroll
    for (int j = 0; j < 4; ++j) { v[j] = v[j] - mean; s2 += (v[j][0] * v[j][0] + v[j][1] * v[j][1]) + (v[j][2] * v[j][2] + v[j][3] * v[j][3]); }
    const float rstd = 1.f / sqrtf(wave_sum(s2) * (1.f / D) + LN_EPS);
#pragma unroll
    for (int j = 0; j < 4; ++j) {
        const f32x4 g = ((const f32x4*)gam)[lane + 64 * j], b = ((const f32x4*)bet)[lane + 64 * j];
        const f32x4 y = v[j] * rstd * g + b;
        if (MODE >= 1) ((f32x4*)of32)[lane + 64 * j] = y;
        if (MODE <= 1) {
            u32x2 w; w.x = pk2(y[0], y[1]); w.y = pk2(y[2], y[3]);
            ((u32x2*)ob0)[lane + 64 * j] = w;
            if (MODE == 0) { u32x2 l; l.x = pk2(y[0] - bf_lo(w.x), y[1] - bf_hi(w.x)); l.y = pk2(y[2] - bf_lo(w.y), y[3] - bf_hi(w.y)); ((u32x2*)ob1)[lane + 64 * j] = l; }
        }
    }
}

__device__ __forceinline__ void sincos_d(float a, float& so, float& co) {
    const double x = (double)a, kq = __builtin_rint(x * 0.63661977236758134308), r = __builtin_fma(-kq, 1.57079632679489661923, x) - kq * 6.123233995736766e-17, r2 = r * r;
    double sp = -2.5052108385441720e-08; sp = sp * r2 + 2.7557319223985893e-06; sp = sp * r2 - 1.9841269841269841e-04; sp = sp * r2 + 8.3333333333333332e-03; sp = sp * r2 - 1.6666666666666666e-01; sp = sp * r2 * r + r;
    double cp = 2.0876756987868099e-09; cp = cp * r2 - 2.7557319223985888e-07; cp = cp * r2 + 2.4801587301587302e-05; cp = cp * r2 - 1.3888888888888889e-03; cp = cp * r2 + 4.1666666666666664e-02; cp = cp * r2 - 0.5; cp = cp * r2 + 1.0;
    const int q = ((int)kq) & 3;
    const double sv = (q == 0) ? sp : (q == 1) ? cp : (q == 2) ? -sp : -cp, cv = (q == 0) ? cp : (q == 1) ? -sp : (q == 2) ? -cp : sp;
    so = (float)sv; co = (float)cv;
}

constexpr int KROW = 144, ATT_KOFF = 0, ATT_VOFF = 256 * KROW;
__device__ __forceinline__ s16x4 tr_read(LAS unsigned char* p) { return __builtin_amdgcn_ds_read_tr16_b64_v4i16((LAS s16x4*)p); }
__device__ __forceinline__ void attn_unit(LAS unsigned char* lds, bf16_t* QO, const bf16_t* Kb, const bf16_t* Vb, float* lse, int unit, int tid, int wid, int lane) {
    const int rb = unit & 15, h = (unit >> 4) & 7, gb = unit >> 7, g = gb % 3, b = gb / 3;
    const int sh = 2 * g, dil = 1 << sh, lgn = 4 - sh, r = rb >> lgn, n = rb & ((1 << lgn) - 1);
    const int col0 = g * 512 + h * 64;
    const size_t rowb = (size_t)b * SEQ;
#pragma unroll
    for (int i = 0; i < 4; ++i) {
        const int idx = tid + i * 512, j = idx >> 3, ch = idx & 7, L = (n - 1) * 128 + j;
        u32x4 kv = {0u, 0u, 0u, 0u}, vv = {0u, 0u, 0u, 0u};
        if (L >= 0) { const size_t off = (rowb + (size_t)(L * dil + r)) * AW + col0 + ch * 8; kv = *(const u32x4*)(Kb + off); vv = *(const u32x4*)(Vb + off); }
        *(LAS u32x4*)(lds + ATT_KOFF + j * KROW + ch * 16) = kv; *(LAS u32x4*)(lds + ATT_VOFF + j * KROW + ch * 16) = vv;
    }
    const int l15 = lane & 15, fq = lane >> 4, qi = wid * 16 + l15;
    const size_t qrow = rowb + (size_t)((n * 128 + qi) * dil + r);
    const bf16x8 q0 = *(const bf16x8*)(QO + qrow * AW + col0 + fq * 8), q1 = *(const bf16x8*)(QO + qrow * AW + col0 + 32 + fq * 8);
    __syncthreads();
    f32x4 s[9];
#pragma unroll
    for (int jb = 0; jb < 9; ++jb) {
        LAS unsigned char* kp = lds + ATT_KOFF + ((wid + jb) * 16 + l15) * KROW + fq * 16;
        const bf16x8 k0 = *(LAS bf16x8*)kp, k1 = *(LAS bf16x8*)(kp + 64);
        f32x4 z = {0.f, 0.f, 0.f, 0.f};
        z = __builtin_amdgcn_mfma_f32_16x16x32_bf16(k0, q0, z, 0, 0, 0);
        s[jb] = __builtin_amdgcn_mfma_f32_16x16x32_bf16(k1, q1, z, 0, 0, 0);
    }
    float mx = -INFINITY;
#pragma unroll
    for (int jb = 0; jb < 9; ++jb)
#pragma unroll
        for (int i = 0; i < 4; ++i) {
            const int dlt = 16 * jb + 4 * fq + i - l15, kj = (wid + jb) * 16 + 4 * fq + i;
            const bool ok = dlt >= 0 && dlt <= 128 && (n > 0 || kj >= 128);
            s[jb][i] = ok ? s[jb][i] : -INFINITY; mx = fmaxf(mx, s[jb][i]);
        }
    mx = fmaxf(mx, __shfl_xor(mx, 16)); mx = fmaxf(mx, __shfl_xor(mx, 32));
    float sum = 0.f;
#pragma unroll
    for (int jb = 0; jb < 9; ++jb)
#pragma unroll
        for (int i = 0; i < 4; ++i) { const float p = __builtin_amdgcn_exp2f(s[jb][i] - mx); s[jb][i] = p; sum += p; }
    sum += __shfl_xor(sum, 16); sum += __shfl_xor(sum, 32);
    const float inv = 1.f / sum;
    bf16x8 pf[5];
    { const f32x4 z = {0.f, 0.f, 0.f, 0.f};
      pf[0] = __builtin_bit_cast(bf16x8, pack8(s[0], s[1])); pf[1] = __builtin_bit_cast(bf16x8, pack8(s[2], s[3])); pf[2] = __builtin_bit_cast(bf16x8, pack8(s[4], s[5]));
      pf[3] = __builtin_bit_cast(bf16x8, pack8(s[6], s[7])); pf[4] = __builtin_bit_cast(bf16x8, pack8(s[8], z)); }
    f32x4 o[4];
#pragma unroll
    for (int db = 0; db < 4; ++db) o[db] = (f32x4){0.f, 0.f, 0.f, 0.f};
    const int qq = l15 >> 2, pp = l15 & 3;
#pragma unroll
    for (int ks = 0; ks < 5; ++ks) {
        const int kb0 = wid + 2 * ks, kb1 = (wid + 2 * ks + 1) > 15 ? 15 : (wid + 2 * ks + 1);
        LAS unsigned char* a0 = lds + ATT_VOFF + (kb0 * 16 + 4 * fq + qq) * KROW + pp * 8;
        LAS unsigned char* a1 = lds + ATT_VOFF + (kb1 * 16 + 4 * fq + qq) * KROW + pp * 8;
#pragma unroll
        for (int db = 0; db < 4; ++db) {
            const s16x4 lo = tr_read(a0 + db * 32), hi = tr_read(a1 + db * 32);
            const bf16x8 vf = {lo[0], lo[1], lo[2], lo[3], hi[0], hi[1], hi[2], hi[3]};
            o[db] = __builtin_amdgcn_mfma_f32_16x16x32_bf16(vf, pf[ks], o[db], 0, 0, 0);
        }
    }
#pragma unroll
    for (int db = 0; db < 4; ++db) {
        u32x2 w; w.x = cvt_pk_bf16(o[db][0] * inv, o[db][1] * inv); w.y = cvt_pk_bf16(o[db][2] * inv, o[db][3] * inv);
        *(u32x2*)(QO + qrow * AW + col0 + db * 16 + 4 * fq) = w;
    }
    if (fq == 0) lse[((size_t)g * M + qrow) * 8 + h] = mx + __builtin_amdgcn_logf(sum);
    __syncthreads();
}

constexpr int GROW = 272;
__device__ __forceinline__ void gmlp_unit(LAS unsigned char* lds, bf16_t* UY, const bf16_t* VG, const float* stats, const float* lng, const float* lnb, const bf16_t* WsB, const float* bs,
                                          int unit, int tid, int wid, int lane) {
    const int g = unit & 7, n = (unit >> 3) & 15, b = unit >> 7;
    const size_t row0 = (size_t)b * SEQ + n * 128;
#pragma unroll
    for (int i = 0; i < 4; ++i) {
        const int idx = tid + i * 512, sr = idx >> 4, ch = idx & 15;
        const u32x4 raw = *(const u32x4*)(VG + (row0 + sr) * D + g * 128 + ch * 8);
        const float s1 = stats[(row0 + sr) * 2], s2 = stats[(row0 + sr) * 2 + 1];
        const float mean = s1 * (1.f / D), var = fmaxf(s2 * (1.f / D) - mean * mean, 0.f), rstd = 1.f / sqrtf(var + LN_EPS);
        const f32x4 g0 = *(const f32x4*)(lng + g * 128 + ch * 8), g1 = *(const f32x4*)(lng + g * 128 + ch * 8 + 4), b0 = *(const f32x4*)(lnb + g * 128 + ch * 8), b1 = *(const f32x4*)(lnb + g * 128 + ch * 8 + 4);
        f32x4 x0, x1; unpack8(raw, x0, x1);
        x0 = (x0 - mean) * rstd * g0 + b0; x1 = (x1 - mean) * rstd * g1 + b1;
        *(LAS u32x4*)(lds + sr * GROW + ch * 16) = pack8(x0, x1);
    }
    const int l15 = lane & 15, fq = lane >> 4, t = wid * 16 + l15;
    bf16x8 wf[4];
#pragma unroll
    for (int ks = 0; ks < 4; ++ks) wf[ks] = *(const bf16x8*)(WsB + ((size_t)g * 128 + t) * 128 + ks * 32 + fq * 8);
    __syncthreads();
    f32x4 acc[8];
#pragma unroll
    for (int cb = 0; cb < 8; ++cb) acc[cb] = (f32x4){0.f, 0.f, 0.f, 0.f};
    const int qq = l15 >> 2, pp = l15 & 3;
#pragma unroll
    for (int ks = 0; ks < 4; ++ks) {
        if (ks * 32 <= wid * 16 + 15) {
            LAS unsigned char* a0 = lds + (ks * 32 + 8 * fq + qq) * GROW + pp * 8;
#pragma unroll
            for (int cb = 0; cb < 8; ++cb) {
                const s16x4 lo = tr_read(a0 + cb * 32), hi = tr_read(a0 + 4 * GROW + cb * 32);
                const bf16x8 vf = {lo[0], lo[1], lo[2], lo[3], hi[0], hi[1], hi[2], hi[3]};
                acc[cb] = __builtin_amdgcn_mfma_f32_16x16x32_bf16(vf, wf[ks], acc[cb], 0, 0, 0);
            }
        }
    }
    const float bst = bs[g * 128 + t];
#pragma unroll
    for (int cb = 0; cb < 8; ++cb) {
        bf16_t* up = UY + (row0 + t) * D + g * 128 + cb * 16 + 4 * fq;
        const u32x2 uw = *(const u32x2*)up;
        u32x2 w; w.x = cvt_pk_bf16(bf_lo(uw.x) * (acc[cb][0] + bst), bf_hi(uw.x) * (acc[cb][1] + bst)); w.y = cvt_pk_bf16(bf_lo(uw.y) * (acc[cb][2] + bst), bf_hi(uw.y) * (acc[cb][3] + bst));
        *(u32x2*)up = w;
    }
    __syncthreads();
}

__device__ const float INV_FREQ[32] = {1.0f, 0.7498942613601685f, 0.5623413324356079f, 0.4216965138912201f, 0.3162277638912201f, 0.23713737726211548f, 0.17782793939113617f, 0.133352130651474f,
            0.10000000149011612f, 0.07498941570520401f, 0.05623413249850273f, 0.04216965287923813f, 0.03162277489900589f, 0.023713737726211548f, 0.017782794311642647f, 0.01333521492779255f,
            0.009999999776482582f, 0.007498941849917173f, 0.005623413249850273f, 0.0042169648222625256f, 0.003162277629598975f, 0.00237137358635664f, 0.0017782794311642647f, 0.0013335214462131262f,
            0.0010000000474974513f, 0.0007498942431993783f, 0.000562341301701963f, 0.0004216965171508491f, 0.0003162277571391314f, 0.00023713737027719617f, 0.00017782794020604342f, 0.0001333521504420787f};
#define XB_TMO      128
#define XB_XCNT(j)  (256  + 64 * (j))
#define XB_XSUB(j)  (1280 + 64 * (j))
#define XB_XGEN(j)  (2304 + 64 * (j))
#define XB_TOP      3328
#define XB_TOPGEN   3392
#define XCD_BAR_WORDS 3456
#define XB_SPIN_CAP (1u << 18)

__device__ __forceinline__ unsigned xb_ld(unsigned* p)              { return __hip_atomic_load(p, __ATOMIC_RELAXED, __HIP_MEMORY_SCOPE_AGENT); }
__device__ __forceinline__ unsigned xb_add(unsigned* p, unsigned v) { return __hip_atomic_fetch_add(p, v, __ATOMIC_RELAXED, __HIP_MEMORY_SCOPE_AGENT); }
__device__ __forceinline__ unsigned xb_xcc_id() { return (unsigned)__builtin_amdgcn_s_getreg((3 << 11) | 20) & 0xFu; }
#define XB_SPIN(cond, bar) do { unsigned _sp = 0; while (cond) { __builtin_amdgcn_s_sleep(1); \
    if ((++_sp & 255u) == 0u) { if (xb_ld(&(bar)[XB_TMO])) break; if (_sp > XB_SPIN_CAP) { atomicAdd(&(bar)[XB_TMO], 1u); break; } } } } while (0)

struct XcdBarrier {
    unsigned* bar; unsigned x;
    volatile LAS unsigned* st;
};

__device__ __forceinline__ XcdBarrier xcd_barrier_post(unsigned* bar, volatile LAS unsigned* st) {
    XcdBarrier b; b.bar = bar; b.x = xb_xcc_id(); b.st = st;
    if (threadIdx.x == 0) (void)xb_add(&bar[XB_XCNT(b.x)], 1u);
    return b;
}
__device__ __forceinline__ void xcd_barrier_complete(unsigned* bar, unsigned x, unsigned& nloc, unsigned& nx) {
    const unsigned G = gridDim.x * gridDim.y * gridDim.z;
    unsigned sum, cnt, mine, sp = 0u;
    for (;;) {
        sum = 0u; cnt = 0u; mine = 0u;
#pragma unroll
        for (unsigned j = 0; j < 16; ++j) { const unsigned c = xb_ld(&bar[XB_XCNT(j)]); sum += c; cnt += (c > 0u) ? 1u : 0u; mine = (j == x) ? c : mine; }
        if (sum == G) break;
        __builtin_amdgcn_s_sleep(1);
        if ((++sp & 255u) == 0u) { if (xb_ld(&bar[XB_TMO])) break; if (sp > XB_SPIN_CAP) { atomicAdd(&bar[XB_TMO], 1u); break; } }
    }
    nloc = mine > 0u ? mine : 1u; nx = cnt > 0u ? cnt : 1u;
}

__device__ __forceinline__ void xcd_barrier(const XcdBarrier& b) {
    asm volatile("s_waitcnt vmcnt(0)" ::: "memory");
    __syncthreads();
    if (threadIdx.x == 0) {
        unsigned* bar = b.bar;
        __builtin_amdgcn_s_waitcnt(0);
        unsigned nloc = b.st[0], nx = b.st[1];
        if (nloc == 0u) { xcd_barrier_complete(bar, b.x, nloc, nx); b.st[0] = nloc; b.st[1] = nx; }
        const unsigned old = xb_add(&bar[XB_XSUB(b.x)], 1u);
        const unsigned gen = old / nloc;
        if (old + 1u == (gen + 1u) * nloc) {
            __builtin_amdgcn_fence(__ATOMIC_RELEASE, "agent");
            asm volatile("s_waitcnt vmcnt(0)" ::: "memory");
            const unsigned og = xb_add(&bar[XB_TOP], 1u);
            const unsigned tg = og / nx;
            if (og + 1u == (tg + 1u) * nx) xb_add(&bar[XB_TOPGEN], 1u);
            else XB_SPIN(xb_ld(&bar[XB_TOPGEN]) == tg, bar);
            __builtin_amdgcn_fence(__ATOMIC_ACQUIRE, "agent");
            xb_add(&bar[XB_XGEN(b.x)], 1u);
            asm volatile("s_waitcnt vmcnt(0)" ::: "memory");
        } else {
            XB_SPIN(xb_ld(&bar[XB_XGEN(b.x)]) == gen, bar);
            __builtin_amdgcn_fence(__ATOMIC_ACQUIRE, "agent");
            asm volatile("s_waitcnt vmcnt(0)" ::: "memory");
        }
    }
    __syncthreads();
}

#define gsync(grid) xcd_barrier(xbar)
constexpr size_t WS_BAR = 256 * 1024;
constexpr int LDS_MISC = 131072 + 64;
struct Args { const float* in[23]; const int* pos; float* out; unsigned char* ws; };

__global__ void __launch_bounds__(NWAVES * 64, 2) fwd_megakernel(Args a) {
    extern __shared__ __attribute__((aligned(16))) unsigned char lds_raw[];
    LAS unsigned char* lds = (LAS unsigned char*)lds_raw;
    cg::grid_group grid = cg::this_grid();
    if (threadIdx.x < 2) ((volatile LAS unsigned*)(lds + LDS_MISC))[threadIdx.x] = 0u;
    __syncthreads();
    const XcdBarrier xbar = xcd_barrier_post((unsigned*)(a.ws + WS_BAR), (volatile LAS unsigned*)(lds + LDS_MISC));
    const int tid = threadIdx.x, lane = tid & 63, wid = __builtin_amdgcn_readfirstlane(tid >> 6);
    const int G = gridDim.x, bx = blockIdx.x;
    const int gw = bx * NWAVES + wid, NGW = G * NWAVES;
    unsigned char* ws = a.ws;
    const float* x = a.in[0];
    bf16_t* Win_t = (bf16_t*)(ws + WS_WIN); bf16_t* Wa_t = (bf16_t*)(ws + WS_WA); bf16_t* Wg_t = (bf16_t*)(ws + WS_WG); bf16_t* Wo_t = (bf16_t*)(ws + WS_WO);
    bf16_t* W1gu_t = (bf16_t*)(ws + WS_W1GU); bf16_t* W1d_t = (bf16_t*)(ws + WS_W1D); bf16_t* W2gu_t = (bf16_t*)(ws + WS_W2GU); bf16_t* W2d_t = (bf16_t*)(ws + WS_W2D);
    float* cosT = (float*)(ws + WS_COS); float* sinT = (float*)(ws + WS_SIN); float* lse = (float*)(ws + WS_LSE); bf16_t* WsB = (bf16_t*)(ws + WS_WSB);
    float* stats = (float*)(ws + WS_STATS);
    bf16_t* XB = (bf16_t*)(ws + WS_XB); bf16_t* ACT1 = (bf16_t*)(ws + WS_ACT1); float* PRE1 = (float*)(ws + WS_PRE1);
    bf16_t* H1HI = (bf16_t*)a.out; bf16_t* H1LO = (bf16_t*)a.out + (size_t)M * D;
    bf16_t* Qb = (bf16_t*)(ws + WS_Q); bf16_t* Kb = (bf16_t*)(ws + WS_K); bf16_t* Vb = (bf16_t*)(ws + WS_V); bf16_t* Ub = (bf16_t*)(ws + WS_U); bf16_t* VGb = (bf16_t*)(ws + WS_VG);
    bf16_t* GATES = (bf16_t*)(ws + WS_GATES); bf16_t* YATT = (bf16_t*)(ws + WS_YATT); bf16_t* MRG = (bf16_t*)(ws + WS_MRG);
    float* PRE2 = (float*)(ws + WS_PRE2); bf16_t* H2B = (bf16_t*)(ws + WS_H2B); bf16_t* ACT2 = (bf16_t*)(ws + WS_ACT2);

    {
        LAS float* scr = (LAS float*)(lds + wid * 16384);
        constexpr int I_GU = 16 * 176, I_D = 44 * 32, I_IN = 16 * 272, I_A = 8 * 32, I_SQ = 16 * 32;
        constexpr int NITEMS = 2 * I_GU + 2 * I_D + I_IN + I_A + 2 * I_SQ;
        for (int it = gw; it < NITEMS; it += NGW) {
            int r = it;
            if (r < I_GU) { tr_gu(a.in[2], a.in[3], W1gu_t, r, scr, lane); continue; } r -= I_GU;
            if (r < I_D) { tr_plain(a.in[4], DFF, D, W1d_t, r, scr, lane); continue; } r -= I_D;
            if (r < I_IN) { tr_win(a.in[7], Win_t, r, scr, lane); continue; } r -= I_IN;
            if (r < I_A) { tr_plain(a.in[13], 512, D, Wa_t, r, scr, lane); continue; } r -= I_A;
            if (r < I_SQ) { tr_plain(a.in[14], D, D, Wg_t, r, scr, lane); continue; } r -= I_SQ;
            if (r < I_SQ) { tr_plain(a.in[15], D, D, Wo_t, r, scr, lane); continue; } r -= I_SQ;
            if (r < I_GU) { tr_gu(a.in[18], a.in[19], W2gu_t, r, scr, lane); continue; } r -= I_GU;
            tr_plain(a.in[20], DFF, D, W2d_t, r, scr, lane);
        }
        for (int m = gw; m < M; m += NGW) {
            const f32x4* xr = (const f32x4*)(x + (size_t)m * D) + lane; u32x2* o = (u32x2*)(XB + (size_t)m * D) + lane;
#pragma unroll
            for (int j = 0; j < 4; ++j) { const f32x4 v = xr[64 * j]; u32x2 w; w.x = pk2(v[0], v[1]); w.y = pk2(v[2], v[3]); o[64 * j] = w; }
        }
        const int gt = bx * (NWAVES * 64) + tid, NGT = G * NWAVES * 64;
        for (int e = gt; e < M * 32; e += NGT) {
            const int row = e >> 5, f = e & 31; const float ang = (float)a.pos[row] * INV_FREQ[f];
            float sv, cv; sincos_d(ang, sv, cv); cosT[e] = cv; sinT[e] = sv;
        }
        for (int e = gt; e < M * 2; e += NGT) stats[e] = 0.f;
        for (int e = gt; e < 8 * 128 * 128; e += NGT) { const int s = e & 127, t = (e >> 7) & 127; WsB[e] = (s <= t) ? (bf16_t)f2bf(a.in[11][e]) : (bf16_t)0; }
    }
    gsync(grid);
    grid.sync();

    { pg8::Gemm g{XB, W1gu_t, M, 2 * DFF, D}; pg8::StaticOrder S; S.init(M, 2 * DFF, G, bx); EpiSwiGLU E{ACT1};
      pg8::gemm_phase<EpiSwiGLU, pg8::StaticOrder, true, true>(lds, g, S, E); }
    gsync(grid);
    { pg8::Gemm g{ACT1, W1d_t, M, D, DFF}; pg8::StaticOrder S; S.init(M, D, G, bx); EpiResid E{x, PRE1, ALPHA, 0.5f};
      pg8::gemm_phase<EpiResid, pg8::StaticOrder, true, true>(lds, g, S, E); }
    gsync(grid);
    for (int m = gw; m < M; m += NGW) ln_row<0>(PRE1 + (size_t)m * D, a.in[5], a.in[6], nullptr, H1HI + (size_t)m * D, H1LO + (size_t)m * D, lane);
    gsync(grid);
    { pg8::Gemm g{H1HI, Win_t, M, 6656, D}; pg8::StaticOrder S; S.init(M, 6656, G, bx); EpiIn E{Qb, Kb, Vb, Ub, VGb, cosT, sinT, stats};
      pg8::gemm_phase<EpiIn, pg8::StaticOrder, true, true>(lds, g, S, E); }
    gsync(grid);
    for (int u = bx; u < 3072 + 1024; u += G) {
        if (u < 3072) attn_unit(lds, Qb, Kb, Vb, lse, u, tid, wid, lane);
        else gmlp_unit(lds, Ub, VGb, stats, a.in[9], a.in[10], WsB, a.in[12], u - 3072, tid, wid, lane);
    }
    gsync(grid);
    for (int m = gw; m < M; m += NGW) {
        const int h = lane >> 3, dc = lane & 7;
        const float l0 = lse[((size_t)0 * M + m) * 8 + h], l1 = lse[((size_t)1 * M + m) * 8 + h], l2 = lse[((size_t)2 * M + m) * 8 + h];
        const float mx = fmaxf(l0, fmaxf(l1, l2));
        float w0 = __builtin_amdgcn_exp2f(l0 - mx), w1 = __builtin_amdgcn_exp2f(l1 - mx), w2 = __builtin_amdgcn_exp2f(l2 - mx);
        const float inv = 1.f / (w0 + w1 + w2); w0 *= inv; w1 *= inv; w2 *= inv;
        const bf16_t* op = Qb + (size_t)m * AW + h * 64 + dc * 8;
        f32x4 a0, a1, b0, b1, c0, c1; unpack8(*(const u32x4*)op, a0, a1); unpack8(*(const u32x4*)(op + 512), b0, b1); unpack8(*(const u32x4*)(op + 1024), c0, c1);
        *(u32x4*)(YATT + (size_t)m * 512 + h * 64 + dc * 8) = pack8(a0 * w0 + b0 * w1 + c0 * w2, a1 * w0 + b1 * w1 + c1 * w2);
    }
    __syncthreads();
    { pg8::Gemm g{H1HI, Win_t + (size_t)6656 * D, M, 2048, D}; pg8::StaticOrder S; S.init(M, 2048, G, bx); EpiGate E{GATES, a.in[8]};
      pg8::gemm_phase<EpiGate, pg8::StaticOrder, true, true>(lds, g, S, E); }
    gsync(grid);
    { pg8::Gemm g{YATT, Wa_t, M, D, 512}; pg8::StaticOrder S; S.init(M, D, G, bx); EpiBranch<0> E{MRG, GATES, 0};
      pg8::gemm_phase<EpiBranch<0>, pg8::StaticOrder, true, true>(lds, g, S, E); }
    { pg8::Gemm g{Ub, Wg_t, M, D, D}; pg8::StaticOrder S; S.init(M, D, G, bx); EpiBranch<1> E{MRG, GATES, 1024};
      pg8::gemm_phase<EpiBranch<1>, pg8::StaticOrder, true, true>(lds, g, S, E); }
    gsync(grid);
    { pg8::Gemm g{MRG, Wo_t, M, D, D}; pg8::StaticOrder S; S.init(M, D, G, bx); EpiResidHL E{H1HI, H1LO, PRE2, ALPHA};
      pg8::gemm_phase<EpiResidHL, pg8::StaticOrder, true, true>(lds, g, S, E); }
    gsync(grid);
    for (int m = gw; m < M; m += NGW) ln_row<1>(PRE2 + (size_t)m * D, a.in[16], a.in[17], PRE2 + (size_t)m * D, H2B + (size_t)m * D, nullptr, lane);
    gsync(grid);
    { pg8::Gemm g{H2B, W2gu_t, M, 2 * DFF, D}; pg8::StaticOrder S; S.init(M, 2 * DFF, G, bx); EpiSwiGLU E{ACT2};
      pg8::gemm_phase<EpiSwiGLU, pg8::StaticOrder, true, true>(lds, g, S, E); }
    gsync(grid);
    { pg8::Gemm g{ACT2, W2d_t, M, D, DFF}; pg8::StaticOrder S; S.init(M, D, G, bx); EpiResid E{PRE2, a.out, ALPHA, 0.5f};
      pg8::gemm_phase<EpiResid, pg8::StaticOrder, true, true>(lds, g, S, E); }
    gsync(grid);
    for (int m = gw; m < M; m += NGW) ln_row<2>(a.out + (size_t)m * D, a.in[21], a.in[22], a.out + (size_t)m * D, nullptr, nullptr, lane);
}

extern "C" void kernel_launch(void* const* d_in, const int* in_sizes, int n_in, void* d_out, int out_size, void* d_ws, size_t ws_size, hipStream_t stream) {
    static int grid = 0;
    if (grid == 0) {
        if (n_in != 23 || in_sizes[0] != M * D || out_size != M * D || ws_size < WS_END) { fprintf(stderr, "kernel_launch: unexpected shapes (n_in %d, in0 %d, out %d, ws %zu)\n", n_in, n_in > 0 ? in_sizes[0] : -1, out_size, ws_size); grid = -1; return; }
        int dev = 0, cus = 0, per_cu = 0;
        if (hipGetDevice(&dev) != hipSuccess || hipDeviceGetAttribute(&cus, hipDeviceAttributeMultiprocessorCount, dev) != hipSuccess) { grid = -1; return; }
        if (hipFuncSetAttribute((const void*)fwd_megakernel, hipFuncAttributeMaxDynamicSharedMemorySize, LDS_BYTES) != hipSuccess) { fprintf(stderr, "kernel_launch: hipFuncSetAttribute failed\n"); grid = -1; return; }
        if (hipOccupancyMaxActiveBlocksPerMultiprocessor(&per_cu, (const void*)fwd_megakernel, NWAVES * 64, LDS_BYTES) != hipSuccess || per_cu < 1) per_cu = 1;
        (void)hipGetLastError();
        grid = cus;
    }
    if (grid < 0) return;
    Args a{};
    for (int i = 0; i < 23; ++i) a.in[i] = (const float*)d_in[i];
    a.pos = (const int*)d_in[1]; a.out = (float*)d_out; a.ws = (unsigned char*)d_ws;
    if (hipMemsetAsync((char*)d_ws + WS_BAR, 0, XCD_BAR_WORDS * 4, stream) != hipSuccess) { fprintf(stderr, "kernel_launch: memset failed\n"); return; }
    void* args[] = {&a};
    hipError_t e = hipLaunchCooperativeKernel((const void*)fwd_megakernel, dim3(grid), dim3(NWAVES * 64), args, LDS_BYTES, stream);
    if (e != hipSuccess) fprintf(stderr, "kernel_launch: cooperative launch failed: %s (grid %d)\n", hipGetErrorString(e), grid);
}
```
